# Optimizing an MI355X kernel written in HIP

```python
import math
import jax, jax.numpy as jnp
from jax import lax
import numpy as np

D_MODEL = 2048
BATCH = 4
SEQ = 2048
DEPTH = 1

MLA_HEADS = 8
MLA_NOPE = 128
MLA_ROPE = 64
MLA_QK = MLA_NOPE + MLA_ROPE
MLA_V = 128
Q_LORA = 512
KV_LORA = 256
ROPE_THETA = 10000.0
Q_BLOCK = 128
ML_HEADS = 8
ML_DQK = 128
ML_DV = 128
ML_CONV = 4
ML_CHUNK = 64
F_BIAS_LO = 3.0
F_BIAS_HI = 6.0
MLA_W = MLA_HEADS * MLA_V
ML_W = ML_HEADS * ML_DV
N_GROUPS = 4
EXP_PER_GROUP = 8
N_EXPERTS = N_GROUPS * EXP_PER_GROUP
TOP_K = 2
D_FF_EXPERT = 512
EPS = 1e-6
IN_SIZES = (Q_LORA, KV_LORA, MLA_ROPE, 2 * ML_HEADS * ML_DQK, ML_HEADS * ML_DV, ML_W, ML_HEADS, ML_HEADS, D_MODEL, D_MODEL)
IN_COLS = Q_LORA + KV_LORA + MLA_ROPE + 2 * ML_HEADS * ML_DQK + ML_HEADS * ML_DV + ML_W + 2 * ML_HEADS + 2 * D_MODEL

kernel_name = "hybrid_mla_mlstm_hmoe_adaln"


def rmsnorm(x, g):
    xf = x.astype(jnp.float32)
    xf = xf * lax.rsqrt(jnp.mean(xf * xf, axis=-1, keepdims=True) + EPS)
    return (xf * g.astype(jnp.float32)).astype(x.dtype)


def rope_tables(positions):
    inv = ROPE_THETA ** (-jnp.arange(0, MLA_ROPE, 2, dtype=jnp.float32) / MLA_ROPE)
    ang = positions.astype(jnp.float32)[..., None] * inv
    return jnp.cos(ang), jnp.sin(ang)


def apply_rope(t, cos, sin):
    cos = cos[:, :, None, :].astype(t.dtype)
    sin = sin[:, :, None, :].astype(t.dtype)
    t1, t2 = jnp.split(t, 2, axis=-1)
    return jnp.concatenate([t1 * cos - t2 * sin, t1 * sin + t2 * cos], axis=-1)


def causal_conv(u, w, b):
    C = u.shape[-1]
    out = lax.conv_general_dilated(u, w[:, None, :].astype(u.dtype), window_strides=(1,), padding=((ML_CONV - 1, 0),), dimension_numbers=('NWC', 'WIO', 'NWC'), feature_group_count=C)
    return out + b.astype(u.dtype)


def mla_attention(cq, ckv, kpe, cos, sin, q_a_norm_g, w_uq, kv_a_norm_g, w_ukv, q_norm_g, k_norm_g):
    B, S, _ = cq.shape
    q = (rmsnorm(cq, q_a_norm_g) @ w_uq).reshape(B, S, MLA_HEADS, MLA_QK)
    kv = (rmsnorm(ckv, kv_a_norm_g) @ w_ukv).reshape(B, S, MLA_HEADS, MLA_NOPE + MLA_V)
    k_nope, v = kv[..., :MLA_NOPE], kv[..., MLA_NOPE:]
    k = jnp.concatenate([k_nope, jnp.broadcast_to(kpe[:, :, None, :], (B, S, MLA_HEADS, MLA_ROPE))], axis=-1)
    q = rmsnorm(q, q_norm_g)
    k = rmsnorm(k, k_norm_g)
    q = jnp.concatenate([q[..., :MLA_NOPE], apply_rope(q[..., MLA_NOPE:], cos, sin)], axis=-1)
    k = jnp.concatenate([k[..., :MLA_NOPE], apply_rope(k[..., MLA_NOPE:], cos, sin)], axis=-1)
    nb = S // Q_BLOCK
    q_blocks = q.reshape(B, nb, Q_BLOCK, MLA_HEADS, MLA_QK).transpose(1, 0, 2, 3, 4)
    key_pos = jnp.arange(S)
    scale = MLA_QK ** -0.5

    def attend(args):
        q_blk, blk = args
        s = jnp.einsum('bqhd,bkhd->bhqk', q_blk, k).astype(jnp.float32) * scale
        q_pos = blk * Q_BLOCK + jnp.arange(Q_BLOCK)
        s = jnp.where(key_pos[None, :] <= q_pos[:, None], s, -jnp.inf)
        p = jax.nn.softmax(s, axis=-1).astype(v.dtype)
        return jnp.einsum('bhqk,bkhd->bqhd', p, v)

    o = lax.map(attend, (q_blocks, jnp.arange(nb)))
    return o.transpose(1, 0, 2, 3, 4).reshape(B, S, MLA_W)


def mlstm_chunkwise(q, k, v, i_pre, f_pre):
    B, S, H, _ = q.shape
    nc = S // ML_CHUNK
    f32 = jnp.float32

    def chunks(t):
        return t.astype(f32).reshape(B, nc, ML_CHUNK, H, -1).transpose(1, 0, 3, 2, 4)

    def gate_chunks(t):
        return t.astype(f32).reshape(B, nc, ML_CHUNK, H).transpose(1, 0, 3, 2)

    qc = chunks(q)
    kc = chunks(k) * (ML_DQK ** -0.5)
    vc = chunks(v)
    log_i = gate_chunks(i_pre)
    b_cum = jnp.cumsum(gate_chunks(jax.nn.log_sigmoid(f_pre.astype(f32))), axis=-1)
    causal = jnp.tril(jnp.ones((ML_CHUNK, ML_CHUNK), dtype=bool))

    def step(carry, inp):
        C, n, m = carry
        q_, k_, v_, b_, li = inp
        log_w = jnp.where(causal, b_[..., :, None] - b_[..., None, :] + li[..., None, :], -jnp.inf)
        log_inter = b_ + m[..., None]
        m_t = jnp.maximum(jnp.max(log_w, axis=-1), log_inter)
        w = jnp.exp(log_w - m_t[..., None])
        a = jnp.exp(log_inter - m_t)
        s = jnp.einsum('bhtd,bhsd->bhts', q_, k_) * w
        num = jnp.einsum('bhts,bhse->bhte', s, v_) + a[..., None] * jnp.einsum('bhtd,bhde->bhte', q_, C)
        den = jnp.sum(s, axis=-1) + a * jnp.einsum('bhtd,bhd->bht', q_, n)
        h = num / jnp.maximum(jnp.abs(den), jnp.exp(-m_t))[..., None]
        b_last = b_[..., -1]
        log_g = b_last[..., None] - b_ + li
        m_new = jnp.maximum(b_last + m, jnp.max(log_g, axis=-1))
        g = jnp.exp(log_g - m_new[..., None])
        decay = jnp.exp(b_last + m - m_new)
        C = decay[..., None, None] * C + jnp.einsum('bhs,bhsd,bhse->bhde', g, k_, v_)
        n = decay[..., None] * n + jnp.einsum('bhs,bhsd->bhd', g, k_)
        return (C, n, m_new), h

    init = (jnp.zeros((B, H, ML_DQK, ML_DV), f32), jnp.zeros((B, H, ML_DQK), f32), jnp.zeros((B, H), f32))
    _, h = lax.scan(step, init, (qc, kc, vc, b_cum, log_i))
    return h.transpose(1, 0, 3, 2, 4).reshape(B, S, H, ML_DV).astype(v.dtype)


def hybrid_mixer(h, cos, sin, w_in, q_a_norm_g, w_uq, kv_a_norm_g, w_ukv, q_norm_g, k_norm_g, conv_w, conv_b, b_mlstm_gates, mlstm_norm_g, w_proj_a, w_proj_b, w_out):
    B, S, _ = h.shape
    proj = h @ w_in
    split_at = np.cumsum(IN_SIZES)[:-1].tolist()
    cq, ckv, kpe, ml_qk, ml_v, ml_o, ml_i, ml_f, g_a, g_b = jnp.split(proj, split_at, axis=-1)
    out_a = mla_attention(cq, ckv, kpe, cos, sin, q_a_norm_g, w_uq, kv_a_norm_g, w_ukv, q_norm_g, k_norm_g)
    qk = jax.nn.silu(causal_conv(ml_qk, conv_w, conv_b))
    ml_q, ml_k = jnp.split(qk, 2, axis=-1)
    ml_q = ml_q.reshape(B, S, ML_HEADS, ML_DQK)
    ml_k = ml_k.reshape(B, S, ML_HEADS, ML_DQK)
    ml_v = ml_v.reshape(B, S, ML_HEADS, ML_DV)
    i_pre = ml_i + b_mlstm_gates[0].astype(ml_i.dtype)
    f_pre = ml_f + b_mlstm_gates[1].astype(ml_f.dtype)
    hm = mlstm_chunkwise(ml_q, ml_k, ml_v, i_pre, f_pre)
    hm = rmsnorm(hm, mlstm_norm_g.reshape(ML_HEADS, ML_DV)).reshape(B, S, ML_W) * jax.nn.sigmoid(ml_o)
    mixed = jax.nn.sigmoid(g_a) * (out_a @ w_proj_a) + jax.nn.sigmoid(g_b) * (hm @ w_proj_b)
    return mixed @ w_out


def hier_moe(h, w_group, b_group, w_router, b_router, w_gate_e, w_up_e, w_down_e):
    B, S, D = h.shape
    t = h.reshape(B * S, D)
    T = t.shape[0]
    g_logits = (t @ w_group).astype(jnp.float32) + b_group.astype(jnp.float32)
    g_prob = jax.nn.softmax(g_logits, axis=-1)
    g_sel = jnp.argmax(g_logits, axis=-1)
    g_w = jnp.take_along_axis(g_prob, g_sel[:, None], axis=-1)[:, 0]
    e_logits = ((t @ w_router).astype(jnp.float32) + b_router.astype(jnp.float32)).reshape(T, N_GROUPS, EXP_PER_GROUP)
    e_in = jnp.take_along_axis(e_logits, g_sel[:, None, None], axis=1)[:, 0]
    top_p, top_i = lax.top_k(jax.nn.softmax(e_in, axis=-1), TOP_K)
    weights = g_w[:, None] * top_p / jnp.sum(top_p, axis=-1, keepdims=True)
    expert_idx = g_sel[:, None] * EXP_PER_GROUP + top_i
    comb = jnp.sum(jax.nn.one_hot(expert_idx, N_EXPERTS, dtype=jnp.float32) * weights[..., None], axis=1).astype(t.dtype)
    out = jnp.zeros_like(t)
    for gi in range(N_GROUPS):
        sl = slice(gi * EXP_PER_GROUP, (gi + 1) * EXP_PER_GROUP)
        hg = jnp.einsum('td,edf->tef', t, w_gate_e[sl])
        hu = jnp.einsum('td,edf->tef', t, w_up_e[sl])
        act = jax.nn.silu(hg) * hu * comb[:, sl, None]
        out = out + jnp.einsum('tef,efd->td', act, w_down_e[sl])
    return out.reshape(B, S, D)


def setup_inputs(seed: int = 0) -> dict:
    key = jax.random.key(seed)
    ks = jax.random.split(key, 32)
    L = DEPTH
    f32 = jnp.float32

    def nrm(k, shape, fan_in):
        return jax.random.normal(k, shape, f32) * (fan_in ** -0.5)

    def gain(k, shape):
        return 1.0 + 0.02 * jax.random.normal(k, shape, f32)

    def bias(k, shape, s=0.01):
        return s * jax.random.normal(k, shape, f32)

    f_bias = jnp.linspace(F_BIAS_LO, F_BIAS_HI, ML_HEADS, dtype=f32)
    b_mlstm_gates = jnp.stack([bias(ks[13], (L, ML_HEADS), 0.1), f_bias[None, :] + bias(ks[14], (L, ML_HEADS), 0.1)], axis=1)
    positions = jnp.arange(SEQ, dtype=jnp.int32)[None, :] + jax.random.randint(ks[2], (BATCH, 1), 0, 1024, dtype=jnp.int32)
    return {
        "x": jax.random.normal(ks[0], (BATCH, SEQ, D_MODEL), f32),
        "c": jax.random.normal(ks[1], (BATCH, D_MODEL), f32),
        "positions": positions,
        "w_ada": nrm(ks[3], (L, D_MODEL, 6 * D_MODEL), D_MODEL),
        "b_ada": bias(ks[4], (L, 6 * D_MODEL), 0.02),
        "norm_mix_g": gain(ks[5], (L, D_MODEL)),
        "w_in": nrm(ks[6], (L, D_MODEL, IN_COLS), D_MODEL),
        "q_a_norm_g": gain(ks[7], (L, Q_LORA)),
        "w_uq": nrm(ks[8], (L, Q_LORA, MLA_HEADS * MLA_QK), Q_LORA),
        "kv_a_norm_g": gain(ks[9], (L, KV_LORA)),
        "w_ukv": nrm(ks[10], (L, KV_LORA, MLA_HEADS * (MLA_NOPE + MLA_V)), KV_LORA),
        "q_norm_g": gain(ks[11], (L, MLA_QK)),
        "k_norm_g": gain(ks[12], (L, MLA_QK)),
        "conv_w": nrm(ks[15], (L, ML_CONV, 2 * ML_HEADS * ML_DQK), ML_CONV),
        "conv_b": bias(ks[16], (L, 2 * ML_HEADS * ML_DQK)),
        "b_mlstm_gates": b_mlstm_gates,
        "mlstm_norm_g": gain(ks[17], (L, ML_W)),
        "w_proj_a": nrm(ks[18], (L, MLA_W, D_MODEL), MLA_W),
        "w_proj_b": nrm(ks[19], (L, ML_W, D_MODEL), ML_W),
        "w_out": nrm(ks[20], (L, D_MODEL, D_MODEL), D_MODEL),
        "norm_ffn_g": gain(ks[21], (L, D_MODEL)),
        "w_group": nrm(ks[22], (L, D_MODEL, N_GROUPS), D_MODEL),
        "b_group": bias(ks[23], (L, N_GROUPS)),
        "w_router": nrm(ks[24], (L, D_MODEL, N_EXPERTS), D_MODEL),
        "b_router": bias(ks[25], (L, N_EXPERTS)),
        "w_gate_e": nrm(ks[26], (L, N_EXPERTS, D_MODEL, D_FF_EXPERT), D_MODEL),
        "w_up_e": nrm(ks[27], (L, N_EXPERTS, D_MODEL, D_FF_EXPERT), D_MODEL),
        "w_down_e": nrm(ks[28], (L, N_EXPERTS, D_FF_EXPERT, D_MODEL), D_FF_EXPERT),
    }


def reference(x, c, positions, w_ada, b_ada, norm_mix_g, w_in, q_a_norm_g, w_uq, kv_a_norm_g, w_ukv, q_norm_g, k_norm_g, conv_w, conv_b, b_mlstm_gates, mlstm_norm_g, w_proj_a, w_proj_b, w_out, norm_ffn_g, w_group, b_group, w_router, b_router, w_gate_e, w_up_e, w_down_e):
    cos, sin = rope_tables(positions)
    cond = jax.nn.silu(c)
    for l in range(DEPTH):
        mod = cond @ w_ada[l] + b_ada[l]
        sh_a, sc_a, gt_a, sh_m, sc_m, gt_m = [m[:, None, :] for m in jnp.split(mod, 6, axis=-1)]
        h = rmsnorm(x, norm_mix_g[l]) * (1.0 + sc_a) + sh_a
        x = x + gt_a * hybrid_mixer(h, cos, sin, w_in[l], q_a_norm_g[l], w_uq[l], kv_a_norm_g[l], w_ukv[l], q_norm_g[l], k_norm_g[l], conv_w[l], conv_b[l], b_mlstm_gates[l], mlstm_norm_g[l], w_proj_a[l], w_proj_b[l], w_out[l])
        h = rmsnorm(x, norm_ffn_g[l]) * (1.0 + sc_m) + sh_m
        x = x + gt_m * hier_moe(h, w_group[l], b_group[l], w_router[l], b_router[l], w_gate_e[l], w_up_e[l], w_down_e[l])
    return x
```

```cpp
#include <hip/hip_runtime.h>
#include <hip/hip_bf16.h>
#include <cstdio>
#include <cstdint>
#include <cmath>

#ifndef MK_N_LAUNCHES
#define MK_N_LAUNCHES 1
#endif

#define LAS __attribute__((address_space(3)))
#define GAS __attribute__((address_space(1)))
typedef unsigned short bf16_t;
typedef short bf16x8 __attribute__((ext_vector_type(8)));
typedef short s16x4 __attribute__((ext_vector_type(4)));
typedef float f32x4 __attribute__((ext_vector_type(4)));
typedef float f32x2 __attribute__((ext_vector_type(2)));
typedef float f32x16 __attribute__((ext_vector_type(16)));
typedef unsigned u32x4 __attribute__((ext_vector_type(4)));
typedef unsigned u32x2 __attribute__((ext_vector_type(2)));
typedef __bf16 bf16x2_t __attribute__((ext_vector_type(2)));
typedef GAS unsigned gu32;

constexpr int DM = 2048, NB = 4, SEQ = 2048, MTOK = NB * SEQ;
constexpr int NH = 8, DQK = 192, DNOPE = 128, DROPE = 64, DV = 128;
constexpr int QL = 512, KVL = 256;
constexpr int INC = 9040, INCP = 9216;
constexpr int NE = 32, DFF = 512;
constexpr float EPS = 1e-6f;
constexpr int SLOT_CAP = 24576;
constexpr float QSCALE = 0.07216878364870322f * 1.4426950408889634f;
constexpr float C2PI_2 = 0.0019353071693331003f, C2PI_3 = 1.0253131677018246e-11f;

constexpr size_t MiB = 1u << 20;
constexpr size_t WS_CTL = 0, CTL_ZERO_BYTES = 1 * MiB;
constexpr size_t WS_MOD = 1 * MiB;
constexpr size_t WS_WUQ = 2 * MiB;
constexpr size_t WS_WUKV = 4 * MiB;
constexpr size_t WS_TOKINFO = 5 * MiB;
constexpr size_t WS_TOKOF = 6 * MiB;
constexpr size_t WS_COMBOF = 7 * MiB;
constexpr size_t WS_WIN = 8 * MiB;
constexpr size_t WS_WPA = 44 * MiB, WS_WPB = 48 * MiB, WS_WOUT = 52 * MiB;
constexpr size_t WS_WGU = 60 * MiB;
constexpr size_t WS_WD = 188 * MiB;
constexpr size_t WS_H = 252 * MiB;
constexpr size_t WS_CQ = 284 * MiB, WS_CKV = 292 * MiB, WS_SM = 296 * MiB;
constexpr size_t WS_MLQK = 304 * MiB, WS_MLV = 336 * MiB, WS_SIGO = 352 * MiB, WS_GA = 368 * MiB, WS_GB = 400 * MiB;
constexpr size_t WS_Y = 304 * MiB;
constexpr size_t WS_ACT = 400 * MiB;
constexpr size_t WS_QRAW = 432 * MiB, WS_KVRAW = 456 * MiB;
constexpr size_t WS_MIXED = 432 * MiB;
constexpr size_t WS_Q = 488 * MiB, WS_K = 512 * MiB, WS_V = 536 * MiB;
constexpr size_t WS_OUTA = 552 * MiB, WS_HM = 568 * MiB;
constexpr size_t WS_END = 584 * MiB;

constexpr int CW_TMO = 0;
constexpr int CW_CNT = 1024;
constexpr int CW_ATTQ = 2048;
constexpr int CW_BAR = 4096;

constexpr int RING_BYTES = 131072;
constexpr int LDSCTL_OFF = RING_BYTES, MISC_OFF = LDSCTL_OFF + 320;
constexpr int LDS_BYTES = 147456;
constexpr int NWAVES = 8;

#define RLX_AGENT __ATOMIC_RELAXED, __HIP_MEMORY_SCOPE_AGENT
#define LDS_WAIT() asm volatile("s_waitcnt lgkmcnt(0)" ::: "memory")
#define VM_WAIT() asm volatile("s_waitcnt vmcnt(0)" ::: "memory")

__device__ __forceinline__ unsigned f2bf(float f) { unsigned u = __builtin_bit_cast(unsigned, f); return (u + 0x7fffu + ((u >> 16) & 1u)) >> 16; }
__device__ __forceinline__ unsigned pk2(float lo, float hi) { f32x2 v = {lo, hi}; bf16x2_t b = __builtin_convertvector(v, bf16x2_t); return __builtin_bit_cast(unsigned, b); }
__device__ __forceinline__ float bflo(unsigned w) { return __builtin_bit_cast(float, w << 16); }
__device__ __forceinline__ float bfhi(unsigned w) { return __builtin_bit_cast(float, w & 0xffff0000u); }
__device__ __forceinline__ float bf1(bf16_t h) { return __builtin_bit_cast(float, (unsigned)h << 16); }
__device__ __forceinline__ float sigm(float x) { return __builtin_amdgcn_rcpf(1.f + __expf(-x)); }
__device__ __forceinline__ float wave_sum(float v) {
#pragma unroll
    for (int o = 1; o < 64; o <<= 1) v += __shfl_xor(v, o);
    return v;
}

namespace pg8 {
constexpr int BM = 256, BK = 64, HALF = 128, HTB = HALF * BK * 2, STAGE_BYTES = 8 * HTB, NXCD = 8, WGM = 8;
__host__ __device__ __forceinline__ int lds_byte(int r, int c) { const int st = (r >> 4) * 2 + (c >> 5), rr = r & 15, cc = c & 31, ob = rr * 64 + cc * 2; return st * 1024 + (ob ^ (((ob >> 9) & 1) << 5)); }
__host__ __device__ __forceinline__ void stage_rc(int b, int& R, int& C) { const int st = b / 1024, sb = b % 1024, swz = sb ^ (((sb >> 9) & 1) << 5); R = (st >> 1) * 16 + swz / 64; C = (st & 1) * 32 + (swz % 64) / 2; }
__host__ __device__ __forceinline__ int perm32(int rho) { const int n = rho >> 4, i = rho & 15; return 8 * (i >> 2) + 4 * n + (i & 3); }

struct Unit { const char* A; const char* B; const char* A2; const char* B2; int pm, pn, e, r0, cnt; };

struct TileOrder {
    int nM, nN, nwg, G, c;
    __device__ __forceinline__ void init(int M, int N, int G_, int c_) { nM = M / BM; nN = N / BM; nwg = nM * nN; G = G_; c = c_; }
    __device__ __forceinline__ bool tile(int i, int& pm, int& pn) const {
        const long L = (long)i * G + c; if (L >= nwg) return false;
        int wgid = (int)L; { const int q = nwg / NXCD, r = nwg % NXCD, xcd = wgid % NXCD, off = wgid / NXCD; wgid = (xcd < r ? xcd * (q + 1) : r * (q + 1) + (xcd - r) * q) + off; }
        const int nig = WGM * nN, gid = wgid / nig, fm = gid * WGM, gsz = (nM - fm) < WGM ? (nM - fm) : WGM;
        pm = fm + ((wgid % nig) % gsz); pn = (wgid % nig) / gsz; return true;
    }
};
struct StaticSched {
    TileOrder T; const char* A; const char* B; int K;
    __device__ __forceinline__ bool next(int i, Unit& u) const { int pm, pn; if (!T.tile(i, pm, pn)) return false; u.pm = pm; u.pn = pn; u.e = 0; u.r0 = 0; u.cnt = 0;
        u.A = A + (size_t)pm * BM * K * 2; u.B = B + (size_t)pn * BM * K * 2; u.A2 = u.A; u.B2 = u.B; return true; }
    __device__ __forceinline__ int tok(const Unit&, int r) const { return r; }
};
struct ChainSched {
    TileOrder T; const char* A0; const char* B0; const char* A1; const char* B1; int K;
    __device__ __forceinline__ bool next(int i, Unit& u) const { int pm, pn; if (!T.tile(i, pm, pn)) return false; u.pm = pm; u.pn = pn; u.e = 0; u.r0 = 0; u.cnt = 0;
        u.A = A0 + (size_t)pm * BM * K * 2; u.B = B0 + (size_t)pn * BM * K * 2; u.A2 = A1 + (size_t)pm * BM * K * 2; u.B2 = B1 + (size_t)pn * BM * K * 2; return true; }
    __device__ __forceinline__ int tok(const Unit&, int r) const { return r; }
};
struct MoeUpSched {
    const LAS int* tstart; const LAS int* cnt; const int* tokof; const char* A; const char* B; int G, c;
    __device__ __forceinline__ bool next(int i, Unit& u) const {
        const int L = i * G + c, ntot = tstart[32] * 4; if (L >= ntot) return false;
        const int T = L >> 2; int e = 0;
        for (int j = 1; j < 32; ++j) e = (T >= tstart[j]) ? j : e;
        e = __builtin_amdgcn_readfirstlane(e);
        const int mt = T - tstart[e];
        u.pm = T; u.pn = L & 3; u.e = e; u.r0 = mt * 256; u.cnt = cnt[e];
        u.A = A; u.B = B + ((size_t)e * 1024 + (size_t)u.pn * 256) * 2048 * 2; u.A2 = u.A; u.B2 = u.B; return true; }
    __device__ __forceinline__ int tok(const Unit& u, int r) const { const int rr = u.r0 + r; return tokof[u.e * 8192 + (rr < u.cnt ? rr : u.r0)]; }
};
struct MoeDownSched {
    const LAS int* tstart; const char* A; const char* B; int G, c;
    __device__ __forceinline__ bool next(int i, Unit& u) const {
        const int L = i * G + c, ntot = tstart[32] * 8; if (L >= ntot) return false;
        const int T = L >> 3; int e = 0;
        for (int j = 1; j < 32; ++j) e = (T >= tstart[j]) ? j : e;
        e = __builtin_amdgcn_readfirstlane(e);
        u.pm = T; u.pn = L & 7; u.e = e; u.r0 = 0; u.cnt = 0;
        u.A = A + (size_t)T * 256 * 512 * 2; u.B = B + ((size_t)e * 2048 + (size_t)u.pn * 256) * 512 * 2; u.A2 = u.A; u.B2 = u.B; return true; }
    __device__ __forceinline__ int tok(const Unit&, int r) const { return r; }
};

template <class Epi, class Sched, bool GATHER, bool CHAIN = false>
__device__ __forceinline__ void gemm_phase(LAS unsigned char* lds, const int K, const Sched& S, const Epi& E) {
    const int tid = threadIdx.x, wid = __builtin_amdgcn_readfirstlane(tid >> 6), lane = tid & 63, wr = wid >> 2, wc = wid & 3, fr = lane & 15, fq = lane >> 4;
    const int nt = K / BK;
    int sR[2], sC[2]; unsigned voffB[2];
#pragma unroll
    for (int i = 0; i < 2; ++i) { int R, C; stage_rc(tid * 16 + i * 8192, R, C); sR[i] = R; sC[i] = C; const int Rb = Epi::PERM ? ((R & ~31) + perm32(R & 31)) : R; voffB[i] = (unsigned)(Rb * K + C) * 2u; }
    const size_t kstep = (size_t)(BK * 2);
    const size_t hstep = (size_t)HALF * K * 2;
    const unsigned ldsw = (unsigned)wid * 1024u;
    const int aoff = lds_byte(wr * 64 + fr, fq * 8), boff = lds_byte(wc * 32 + fr, fq * 8);
#define PG8_SA(b, h) (((b) * 2 + (h)) * HTB)
#define PG8_SB(b, h) ((4 + (b) * 2 + (h)) * HTB)
#define PG8_STAGE(bufoff, gbase, voff) do { _Pragma("unroll") for (int _i = 0; _i < 2; ++_i) \
        __builtin_amdgcn_global_load_lds((const unsigned*)((const char*)(gbase) + (voff)[_i]), (LAS unsigned*)(lds + (bufoff) + ldsw + _i * 8192), 16, 0, 0); } while (0)
#define PG8_LDA(dst, b, h) do { _Pragma("unroll") for (int m = 0; m < 4; ++m) _Pragma("unroll") for (int k = 0; k < 2; ++k) dst[m][k] = *(const LAS bf16x8*)(lds + PG8_SA(b, h) + aoff + m * 2048 + k * 1024); } while (0)
#define PG8_LDB(dst, b, h) do { _Pragma("unroll") for (int n = 0; n < 2; ++n) _Pragma("unroll") for (int k = 0; k < 2; ++k) dst[n][k] = *(const LAS bf16x8*)(lds + PG8_SB(b, h) + boff + n * 2048 + k * 1024); } while (0)
#define PG8_MMA(ai, bj, At, Bt) do { __builtin_amdgcn_s_setprio(1); _Pragma("unroll") for (int m = 0; m < 4; ++m) _Pragma("unroll") for (int n = 0; n < 2; ++n) _Pragma("unroll") for (int k = 0; k < 2; ++k) \
        acc[ai][bj][m][n] = __builtin_amdgcn_mfma_f32_16x16x32_bf16(Bt[n][k], At[m][k], acc[ai][bj][m][n], 0, 0, 0); __builtin_amdgcn_s_setprio(0); } while (0)
#define PG8_WAIT_V(n) asm volatile("s_waitcnt vmcnt(" #n ")" ::: "memory")
#define PG8_WAIT_L(n) asm volatile("s_waitcnt lgkmcnt(" #n ")" ::: "memory")
#define PG8_BAR __builtin_amdgcn_s_barrier()
#define PG8_SCHED __builtin_amdgcn_sched_barrier(0)
#define PG8_OFFS(dst, unit) do { _Pragma("unroll") for (int _h = 0; _h < 2; ++_h) _Pragma("unroll") for (int _i = 0; _i < 2; ++_i) { \
        const int _row = GATHER ? S.tok(unit, _h * HALF + sR[_i]) : (_h * HALF + sR[_i]); dst[_h][_i] = (unsigned)(_row * K + sC[_i]) * 2u; } } while (0)
#define PG8_KLOOP(cA_, cB_, nA_, nB_, useN_) do { \
        for (int t = 0; t < nt; t += 2) { \
            const bool last = (t == nt - 2); \
            const char* a1 = (cA_) + (size_t)(t + 1) * kstep; \
            const char* a2 = last ? (nA_) : (cA_) + (size_t)(t + 2) * kstep; const char* b2 = last ? (nB_) : (cB_) + (size_t)(t + 2) * kstep; \
            const char* a3 = a2 + kstep; const char* b3 = b2 + kstep; \
            unsigned o2[2][2]; \
_Pragma("unroll") \
            for (int h = 0; h < 2; ++h) \
_Pragma("unroll") \
                for (int i = 0; i < 2; ++i) o2[h][i] = (GATHER && last && (useN_)) ? voN[h][i] : voA[h][i]; \
            PG8_LDB(B0, 0, 0); PG8_LDB(B1, 0, 1); PG8_SCHED; PG8_LDA(At, 0, 0); PG8_STAGE(PG8_SA(1, 1), a1, voA[1]); \
            PG8_WAIT_V(8); PG8_WAIT_L(0); PG8_BAR; PG8_MMA(0, 0, At, B0); PG8_MMA(0, 1, At, B1); PG8_BAR; PG8_SCHED; \
            PG8_LDA(At, 0, 1); PG8_STAGE(PG8_SB(0, 0), b2, voffB); PG8_STAGE(PG8_SB(0, 1), b2 + hstep, voffB); PG8_STAGE(PG8_SA(0, 0), a2, o2[0]); \
            PG8_WAIT_V(8); PG8_WAIT_L(0); PG8_BAR; PG8_MMA(1, 0, At, B0); PG8_MMA(1, 1, At, B1); PG8_BAR; PG8_SCHED; \
            PG8_LDB(B0, 1, 0); PG8_LDB(B1, 1, 1); PG8_SCHED; PG8_LDA(At, 1, 0); PG8_STAGE(PG8_SA(0, 1), a2, o2[1]); \
            PG8_WAIT_V(8); PG8_WAIT_L(0); PG8_BAR; PG8_MMA(0, 0, At, B0); PG8_MMA(0, 1, At, B1); PG8_BAR; PG8_SCHED; \
            PG8_LDA(At, 1, 1); PG8_STAGE(PG8_SB(1, 0), b3, voffB); PG8_STAGE(PG8_SB(1, 1), b3 + hstep, voffB); PG8_STAGE(PG8_SA(1, 0), a3, o2[0]); \
            PG8_WAIT_V(8); PG8_WAIT_L(0); PG8_BAR; PG8_MMA(1, 0, At, B0); PG8_MMA(1, 1, At, B1); PG8_BAR; PG8_SCHED; \
        } \
    } while (0)
    Unit cur, nxt; int ui = 0;
    if (!S.next(0, cur)) return;
    f32x4 acc[2][2][4][2];
#pragma unroll
    for (int a = 0; a < 2; ++a)
#pragma unroll
        for (int b = 0; b < 2; ++b)
#pragma unroll
            for (int m = 0; m < 4; ++m)
#pragma unroll
                for (int n = 0; n < 2; ++n) acc[a][b][m][n] = (f32x4){0.f, 0.f, 0.f, 0.f};
    bf16x8 At[4][2], B0[2][2], B1[2][2];
    unsigned voA[2][2], voN[2][2];
    PG8_OFFS(voA, cur);
    const char* cA = cur.A; const char* cB = cur.B;
    PG8_STAGE(PG8_SB(0, 0), cB, voffB); PG8_STAGE(PG8_SB(0, 1), cB + hstep, voffB); PG8_STAGE(PG8_SA(0, 0), cA, voA[0]); PG8_STAGE(PG8_SA(0, 1), cA, voA[1]);
    if (wr == 1) PG8_BAR;
    PG8_WAIT_V(2); PG8_BAR;
    PG8_STAGE(PG8_SB(1, 0), cB + kstep, voffB); PG8_STAGE(PG8_SA(1, 0), cA + kstep, voA[0]); PG8_STAGE(PG8_SB(1, 1), cB + hstep + kstep, voffB);
    PG8_WAIT_V(6); PG8_BAR;
    for (;;) {
        const bool has_next = S.next(ui + 1, nxt);
        const char* nA = has_next ? nxt.A : cA; const char* nB = has_next ? nxt.B : cB;
        if (GATHER) { if (has_next) { PG8_OFFS(voN, nxt); } else {
#pragma unroll
            for (int h = 0; h < 2; ++h)
#pragma unroll
                for (int i = 0; i < 2; ++i) voN[h][i] = voA[h][i]; } }
        if constexpr (CHAIN) { PG8_KLOOP(cA, cB, cur.A2, cur.B2, false); E.mid(acc, cur, wr, wc, fr, fq); PG8_KLOOP(cur.A2, cur.B2, nA, nB, true); }
        else { PG8_KLOOP(cA, cB, nA, nB, true); }
        if (wr == 0) PG8_BAR;
        E(acc, cur, wr, wc, fr, fq);
        if (!has_next) break;
        {
#pragma unroll
            for (int a = 0; a < 2; ++a)
#pragma unroll
                for (int b = 0; b < 2; ++b)
#pragma unroll
                    for (int m = 0; m < 4; ++m)
#pragma unroll
                        for (int n = 0; n < 2; ++n) acc[a][b][m][n] = (f32x4){0.f, 0.f, 0.f, 0.f};
        }
        cur = nxt; cA = nA; cB = nB; ++ui;
        if (GATHER) {
#pragma unroll
            for (int h = 0; h < 2; ++h)
#pragma unroll
                for (int i = 0; i < 2; ++i) voA[h][i] = voN[h][i]; }
        if (wr == 1) PG8_BAR;
    }
    PG8_WAIT_V(0);
    PG8_BAR;
#undef PG8_SA
#undef PG8_SB
#undef PG8_STAGE
#undef PG8_LDA
#undef PG8_LDB
#undef PG8_MMA
#undef PG8_WAIT_V
#undef PG8_WAIT_L
#undef PG8_BAR
#undef PG8_SCHED
#undef PG8_OFFS
#undef PG8_KLOOP
}

struct EpiBf16 {
    static constexpr bool PERM = true;
    bf16_t* O; int ldc;
    __device__ __forceinline__ void mid(f32x4 (&)[2][2][4][2], const Unit&, int, int, int, int) const {}
    __device__ __forceinline__ void operator()(const f32x4 (&acc)[2][2][4][2], const Unit& u, int wr, int wc, int fr, int fq) const {
        const int row0 = u.pm * BM + wr * 64 + fr, col0 = u.pn * BM + wc * 32 + 8 * fq;
#pragma unroll
        for (int ai = 0; ai < 2; ++ai)
#pragma unroll
            for (int m = 0; m < 4; ++m) { bf16_t* rowp = O + (size_t)(row0 + ai * HALF + m * 16) * ldc + col0;
#pragma unroll
                for (int bj = 0; bj < 2; ++bj) { const f32x4 v0 = acc[ai][bj][m][0], v1 = acc[ai][bj][m][1];
                    u32x4 w; w.x = pk2(v0[0], v0[1]); w.y = pk2(v0[2], v0[3]); w.z = pk2(v1[0], v1[1]); w.w = pk2(v1[2], v1[3]);
                    *(u32x4*)(rowp + bj * HALF) = w; } }
    }
};
struct EpiProj {
    static constexpr bool PERM = true;
    unsigned char* ws;
    __device__ __forceinline__ void mid(f32x4 (&)[2][2][4][2], const Unit&, int, int, int, int) const {}
    __device__ __forceinline__ void operator()(const f32x4 (&acc)[2][2][4][2], const Unit& u, int wr, int wc, int fr, int fq) const {
        const int pn = u.pn; size_t boff; int ldc, colt, mode = 0;
        if (pn < 2) { boff = WS_CQ; ldc = 512; colt = pn * 256; }
        else if (pn == 2) { boff = WS_CKV; ldc = 256; colt = 0; }
        else if (pn == 3) { boff = WS_SM; ldc = 256; colt = 0; mode = 2; }
        else if (pn < 12) { boff = WS_MLQK; ldc = 2048; colt = (pn - 4) * 256; }
        else if (pn < 16) { boff = WS_MLV; ldc = 1024; colt = (pn - 12) * 256; }
        else if (pn < 20) { boff = WS_SIGO; ldc = 1024; colt = (pn - 16) * 256; mode = 1; }
        else if (pn < 28) { boff = WS_GA; ldc = 2048; colt = (pn - 20) * 256; mode = 1; }
        else { boff = WS_GB; ldc = 2048; colt = (pn - 28) * 256; mode = 1; }
        const int row0 = u.pm * BM + wr * 64 + fr, col0 = colt + wc * 32 + 8 * fq;
        if (mode == 2) {
            float* O = (float*)(ws + boff);
#pragma unroll
            for (int ai = 0; ai < 2; ++ai)
#pragma unroll
                for (int m = 0; m < 4; ++m) { float* rowp = O + (size_t)(row0 + ai * HALF + m * 16) * ldc + col0;
#pragma unroll
                    for (int bj = 0; bj < 2; ++bj) { *(f32x4*)(rowp + bj * HALF) = acc[ai][bj][m][0]; *(f32x4*)(rowp + bj * HALF + 4) = acc[ai][bj][m][1]; } }
        } else {
            bf16_t* O = (bf16_t*)(ws + boff);
#pragma unroll
            for (int ai = 0; ai < 2; ++ai)
#pragma unroll
                for (int m = 0; m < 4; ++m) { bf16_t* rowp = O + (size_t)(row0 + ai * HALF + m * 16) * ldc + col0;
#pragma unroll
                    for (int bj = 0; bj < 2; ++bj) { f32x4 v0 = acc[ai][bj][m][0], v1 = acc[ai][bj][m][1];
                        if (mode == 1) { v0 = (f32x4){sigm(v0[0]), sigm(v0[1]), sigm(v0[2]), sigm(v0[3])}; v1 = (f32x4){sigm(v1[0]), sigm(v1[1]), sigm(v1[2]), sigm(v1[3])}; }
                        u32x4 w; w.x = pk2(v0[0], v0[1]); w.y = pk2(v0[2], v0[3]); w.z = pk2(v1[0], v1[1]); w.w = pk2(v1[2], v1[3]);
                        *(u32x4*)(rowp + bj * HALF) = w; } }
        }
    }
};
struct EpiMix {
    static constexpr bool PERM = true;
    const bf16_t* GA; const bf16_t* GB; bf16_t* O;
    __device__ __forceinline__ void mid(f32x4 (&acc)[2][2][4][2], const Unit& u, int wr, int wc, int fr, int fq) const {
        const int row0 = u.pm * BM + wr * 64 + fr, col0 = u.pn * BM + wc * 32 + 8 * fq;
#pragma unroll
        for (int ai = 0; ai < 2; ++ai)
#pragma unroll
            for (int m = 0; m < 4; ++m) { const size_t off = (size_t)(row0 + ai * HALF + m * 16) * DM + col0;
#pragma unroll
                for (int bj = 0; bj < 2; ++bj) { const u32x4 a = *(const u32x4*)(GA + off + bj * HALF), b = *(const u32x4*)(GB + off + bj * HALF);
                    f32x4 r0 = {bflo(a.x) * __builtin_amdgcn_rcpf(bflo(b.x)), bfhi(a.x) * __builtin_amdgcn_rcpf(bfhi(b.x)), bflo(a.y) * __builtin_amdgcn_rcpf(bflo(b.y)), bfhi(a.y) * __builtin_amdgcn_rcpf(bfhi(b.y))};
                    f32x4 r1 = {bflo(a.z) * __builtin_amdgcn_rcpf(bflo(b.z)), bfhi(a.z) * __builtin_amdgcn_rcpf(bfhi(b.z)), bflo(a.w) * __builtin_amdgcn_rcpf(bflo(b.w)), bfhi(a.w) * __builtin_amdgcn_rcpf(bfhi(b.w))};
                    acc[ai][bj][m][0] = acc[ai][bj][m][0] * r0; acc[ai][bj][m][1] = acc[ai][bj][m][1] * r1;
                    asm volatile("" : "+v"(acc[ai][bj][m][0]), "+v"(acc[ai][bj][m][1]) :: "memory"); } }
    }
    __device__ __forceinline__ void operator()(const f32x4 (&acc)[2][2][4][2], const Unit& u, int wr, int wc, int fr, int fq) const {
        int row0 = u.pm * BM + wr * 64 + fr, col0 = u.pn * BM + wc * 32 + 8 * fq;
        asm volatile("" : "+v"(row0), "+v"(col0));
#pragma unroll
        for (int ai = 0; ai < 2; ++ai)
#pragma unroll
            for (int m = 0; m < 4; ++m) { const size_t off = (size_t)(row0 + ai * HALF + m * 16) * DM + col0;
#pragma unroll
                for (int bj = 0; bj < 2; ++bj) { const u32x4 b = *(const u32x4*)(GB + off + bj * HALF);
                    const f32x4 v0 = acc[ai][bj][m][0], v1 = acc[ai][bj][m][1];
                    u32x4 w; w.x = pk2(v0[0] * bflo(b.x), v0[1] * bfhi(b.x)); w.y = pk2(v0[2] * bflo(b.y), v0[3] * bfhi(b.y));
                    w.z = pk2(v1[0] * bflo(b.z), v1[1] * bfhi(b.z)); w.w = pk2(v1[2] * bflo(b.w), v1[3] * bfhi(b.w));
                    *(u32x4*)(O + off + bj * HALF) = w; }
                asm volatile("" ::: "memory"); }
    }
};
struct EpiOut {
    static constexpr bool PERM = false;
    const float* X; const float* mod; float* O;
    __device__ __forceinline__ void mid(f32x4 (&)[2][2][4][2], const Unit&, int, int, int, int) const {}
    __device__ __forceinline__ void operator()(const f32x4 (&acc)[2][2][4][2], const Unit& u, int wr, int wc, int fr, int fq) const {
        const int row0 = u.pm * BM + wr * 64 + fr, col0 = u.pn * BM + wc * 32 + 4 * fq;
        const float* gt = mod + (size_t)(u.pm >> 3) * 12288 + 4096 + col0;
        f32x4 gv[2][2];
#pragma unroll
        for (int bj = 0; bj < 2; ++bj)
#pragma unroll
            for (int n = 0; n < 2; ++n) gv[bj][n] = *(const f32x4*)(gt + bj * HALF + n * 16);
#pragma unroll
        for (int ai = 0; ai < 2; ++ai)
#pragma unroll
            for (int m = 0; m < 4; ++m) { const size_t off = (size_t)(row0 + ai * HALF + m * 16) * DM + col0;
#pragma unroll
                for (int bj = 0; bj < 2; ++bj)
#pragma unroll
                    for (int n = 0; n < 2; ++n) { const f32x4 xv = *(const f32x4*)(X + off + bj * HALF + n * 16);
                        *(f32x4*)(O + off + bj * HALF + n * 16) = xv + gv[bj][n] * acc[ai][bj][m][n]; } }
    }
};
struct EpiMoeUp {
    static constexpr bool PERM = true;
    const float* combof; bf16_t* ACT;
    __device__ __forceinline__ void mid(f32x4 (&)[2][2][4][2], const Unit&, int, int, int, int) const {}
    __device__ __forceinline__ void operator()(const f32x4 (&acc)[2][2][4][2], const Unit& u, int wr, int wc, int fr, int fq) const {
        const int col0 = u.pn * HALF + wc * 32 + 8 * fq;
#pragma unroll
        for (int ai = 0; ai < 2; ++ai)
#pragma unroll
            for (int m = 0; m < 4; ++m) { const int r = ai * HALF + wr * 64 + m * 16 + fr; const int rr = u.r0 + r;
                const float cb = (rr < u.cnt) ? combof[u.e * 8192 + rr] : 0.f;
                const f32x4 g0 = acc[ai][0][m][0], g1 = acc[ai][0][m][1], u0 = acc[ai][1][m][0], u1 = acc[ai][1][m][1];
                u32x4 w;
                w.x = pk2(g0[0] * sigm(g0[0]) * u0[0] * cb, g0[1] * sigm(g0[1]) * u0[1] * cb); w.y = pk2(g0[2] * sigm(g0[2]) * u0[2] * cb, g0[3] * sigm(g0[3]) * u0[3] * cb);
                w.z = pk2(g1[0] * sigm(g1[0]) * u1[0] * cb, g1[1] * sigm(g1[1]) * u1[1] * cb); w.w = pk2(g1[2] * sigm(g1[2]) * u1[2] * cb, g1[3] * sigm(g1[3]) * u1[3] * cb);
                *(u32x4*)(ACT + (size_t)(u.pm * BM + r) * DFF + col0) = w; }
    }
};
}

#define XB_TMO      128
#define XB_XCNT(j)  (256  + 64 * (j))
#define XB_XSUB(j)  (1280 + 64 * (j))
#define XB_XGEN(j)  (2304 + 64 * (j))
#define XB_TOP      3328
#define XB_TOPGEN   3392
#define XCD_BAR_WORDS 3456
#define XB_SPIN_CAP (1u << 18)
__device__ __forceinline__ unsigned xb_ld(unsigned* p)              { return __hip_atomic_load(p, __ATOMIC_RELAXED, __HIP_MEMORY_SCOPE_AGENT); }
__device__ __forceinline__ unsigned xb_add(unsigned* p, unsigned v) { return __hip_atomic_fetch_add(p, v, __ATOMIC_RELAXED, __HIP_MEMORY_SCOPE_AGENT); }
__device__ __forceinline__ unsigned xb_xcc_id() { return (unsigned)__builtin_amdgcn_s_getreg((3 << 11) | 20) & 0xFu; }
#define XB_SPIN(cond, bar) do { unsigned _sp = 0; while (cond) { __builtin_amdgcn_s_sleep(1); \
    if ((++_sp & 255u) == 0u) { if (xb_ld(&(bar)[XB_TMO])) break; if (_sp > XB_SPIN_CAP) { atomicAdd(&(bar)[XB_TMO], 1u); break; } } } } while (0)
struct XcdBarrier { unsigned* bar; unsigned x; volatile LAS unsigned* st; };
__device__ __forceinline__ XcdBarrier xcd_barrier_post(unsigned* bar, volatile LAS unsigned* st) {
    XcdBarrier b; b.bar = bar; b.x = xb_xcc_id(); b.st = st;
    if (threadIdx.x == 0) (void)xb_add(&bar[XB_XCNT(b.x)], 1u);
    return b;
}
__device__ __forceinline__ void xcd_barrier_complete(unsigned* bar, unsigned x, unsigned& nloc, unsigned& nx) {
    const unsigned G = gridDim.x * gridDim.y * gridDim.z;
    unsigned sum, cnt, mine, sp = 0u;
    for (;;) {
        sum = 0u; cnt = 0u; mine = 0u;
#pragma unroll
        for (unsigned j = 0; j < 16; ++j) { const unsigned c = xb_ld(&bar[XB_XCNT(j)]); sum += c; cnt += (c > 0u) ? 1u : 0u; mine = (j == x) ? c : mine; }
        if (sum == G) break;
        __builtin_amdgcn_s_sleep(1);
        if ((++sp & 255u) == 0u) { if (xb_ld(&bar[XB_TMO])) break; if (sp > XB_SPIN_CAP) { atomicAdd(&bar[XB_TMO], 1u); break; } }
    }
    nloc = mine > 0u ? mine : 1u; nx = cnt > 0u ? cnt : 1u;
}
__device__ __forceinline__ void xcd_barrier(const XcdBarrier& b) {
    asm volatile("s_waitcnt vmcnt(0)" ::: "memory");
    __syncthreads();
    if (threadIdx.x == 0) {
        unsigned* bar = b.bar;
        __builtin_amdgcn_s_waitcnt(0);
        unsigned nloc = b.st[0], nx = b.st[1];
        if (nloc == 0u) { xcd_barrier_complete(bar, b.x, nloc, nx); b.st[0] = nloc; b.st[1] = nx; }
        const unsigned old = xb_add(&bar[XB_XSUB(b.x)], 1u);
        const unsigned gen = old / nloc;
        if (old + 1u == (gen + 1u) * nloc) {
            __builtin_amdgcn_fence(__ATOMIC_RELEASE, "agent");
            asm volatile("s_waitcnt vmcnt(0)" ::: "memory");
            const unsigned og = xb_add(&bar[XB_TOP], 1u);
            const unsigned tg = og / nx;
            if (og + 1u == (tg + 1u) * nx) xb_add(&bar[XB_TOPGEN], 1u);
            else XB_SPIN(xb_ld(&bar[XB_TOPGEN]) == tg, bar);
            __builtin_amdgcn_fence(__ATOMIC_ACQUIRE, "agent");
            xb_add(&bar[XB_XGEN(b.x)], 1u);
            asm volatile("s_waitcnt vmcnt(0)" ::: "memory");
        } else {
            XB_SPIN(xb_ld(&bar[XB_XGEN(b.x)]) == gen, bar);
            __builtin_amdgcn_fence(__ATOMIC_ACQUIRE, "agent");
            asm volatile("s_waitcnt vmcnt(0)" ::: "memory");
        }
    }
    __syncthreads();
}

struct Args { const void* in[28]; float* out; unsigned char* ws; float inv_freq[32]; int ph_lo, ph_hi, li, pad; };
constexpr int PER_PHASE = 12;

template <class RowMap>
__device__ __forceinline__ void p0_transpose_item(const float* W, int K, int N, bf16_t* WT, LAS float* scr, int item, int lane, const float* kscale, const RowMap& rm) {
    const int nblk = (N + 31) / 32, kb = item / nblk, nb = item % nblk, k0 = 64 * kb, n0 = 32 * nb;
    const int ncol = n0 + (lane & 31);
#pragma unroll 8
    for (int i = 0; i < 32; ++i) { const int kk = 2 * i + (lane >> 5); float v = 0.f; if (ncol < N) { v = W[(size_t)(k0 + kk) * N + ncol]; if (kscale) v *= kscale[k0 + kk]; } scr[kk * 33 + (lane & 31)] = v; }
    LDS_WAIT(); asm volatile("" ::: "memory");
    const int c = lane & 7;
#pragma unroll
    for (int j = 0; j < 4; ++j) { const int n = (lane >> 3) + 8 * j; const LAS float* s = scr + (8 * c) * 33 + n;
        u32x4 o; o.x = pk2(s[0 * 33], s[1 * 33]); o.y = pk2(s[2 * 33], s[3 * 33]); o.z = pk2(s[4 * 33], s[5 * 33]); o.w = pk2(s[6 * 33], s[7 * 33]);
        if (n0 + n < N) *(GAS u32x4*)(WT + (size_t)rm(n0 + n) * K + k0 + 8 * c) = o; }
    LDS_WAIT(); asm volatile("" ::: "memory");
}
struct RmId { __device__ __forceinline__ int operator()(int n) const { return n; } };
struct RmWin { __device__ __forceinline__ int operator()(int n) const {
    if (n < 832) return n; if (n < 2880) return 1024 + (n - 832); if (n < 3904) return 3072 + (n - 2880); if (n < 4928) return 4096 + (n - 3904);
    if (n < 4936) return 832 + (n - 4928); if (n < 4944) return 840 + (n - 4936); if (n < 6992) return 5120 + (n - 4944); return 7168 + (n - 6992); } };
struct RmGate { int base; __device__ __forceinline__ int operator()(int f) const { return base + (f >> 7) * 256 + (f & 127); } };

namespace att {
constexpr int KROW = 400, VROW = 136, K_OFF = 0, V_OFF = 64 * KROW;
__device__ __forceinline__ int crow(int r, int hi) { return (r & 3) + 8 * (r >> 2) + 4 * hi; }
#define MFMA32(a, b, c) __builtin_amdgcn_mfma_f32_32x32x16_bf16((a), (b), (c), 0, 0, 0)
__device__ __forceinline__ void unit(int b, int h, int qb, const bf16_t* Q, const bf16_t* Kg, const bf16_t* Vg, bf16_t* OUTA, LAS unsigned char* lds) {
    const int tid = threadIdx.x, lane = tid & 63, ql = lane & 31, hi = lane >> 5; const int wid = __builtin_amdgcn_readfirstlane(tid >> 6);
    const size_t bh = (size_t)(b * NH + h);
    const int q0 = qb * 256 + wid * 32;
    const bf16_t* Qp = Q + (bh * SEQ + q0 + ql) * DQK;
    bf16x8 qf[12];
#pragma unroll
    for (int s = 0; s < 12; ++s) qf[s] = *(const bf16x8*)(Qp + 16 * s + 8 * hi);
    f32x16 o[4];
#pragma unroll
    for (int d = 0; d < 4; ++d) o[d] = f32x16{};
    float mrun = -1e30f, lrun = 0.f;
    const int ntile = 4 * qb + 4;
    const bf16_t* Kb = Kg + bh * SEQ * DQK; const bf16_t* Vb = Vg + bh * SEQ * DV;
    const int vhw = tid >> 5, vsp = tid & 31;
    u32x4 kreg[3], vreg[2];
#define ATT_LOAD(j) do { _Pragma("unroll") for (int i = 0; i < 3; ++i) kreg[i] = *(const u32x4*)(Kb + (size_t)(j) * 64 * DQK + (size_t)(tid + 512 * i) * 8); \
        vreg[0] = *(const u32x4*)(Vb + ((size_t)(j) * 64 + 2 * vsp) * DV + 8 * vhw); vreg[1] = *(const u32x4*)(Vb + ((size_t)(j) * 64 + 2 * vsp + 1) * DV + 8 * vhw); } while (0)
    ATT_LOAD(0);
    for (int j = 0; j < ntile; ++j) {
        __syncthreads();
#pragma unroll
        for (int i = 0; i < 3; ++i) { const int p = tid + 512 * i, row = p / 24, c = p % 24; *(LAS u32x4*)(lds + K_OFF + row * KROW + 16 * c) = kreg[i]; }
        {
            const unsigned a[4] = {vreg[0].x, vreg[0].y, vreg[0].z, vreg[0].w}, c2[4] = {vreg[1].x, vreg[1].y, vreg[1].z, vreg[1].w};
#pragma unroll
            for (int jj = 0; jj < 4; ++jj) {
                const unsigned lo = (a[jj] & 0xffffu) | (c2[jj] << 16), hi2 = (a[jj] >> 16) | (c2[jj] & 0xffff0000u);
                *(LAS unsigned*)(lds + V_OFF + (8 * vhw + 2 * jj) * VROW + 4 * vsp) = lo;
                *(LAS unsigned*)(lds + V_OFF + (8 * vhw + 2 * jj + 1) * VROW + 4 * vsp) = hi2;
            }
        }
        __syncthreads();
        if (j + 1 < ntile) ATT_LOAD(j + 1);
        if (64 * j <= q0 + 31) {
            f32x16 p0 = f32x16{}, p1 = f32x16{};
            const LAS unsigned char* kp = lds + K_OFF + ql * KROW + 16 * hi;
#pragma unroll
            for (int s = 0; s < 12; ++s) {
                const bf16x8 k0 = *(const LAS bf16x8*)(kp + 32 * s), k1 = *(const LAS bf16x8*)(kp + 32 * KROW + 32 * s);
                p0 = MFMA32(k0, qf[s], p0); p1 = MFMA32(k1, qf[s], p1);
                asm volatile("" ::: "memory");
            }
            if (64 * j + 63 > q0) {
                const int qa = q0 + ql - 64 * j;
#pragma unroll
                for (int r = 0; r < 16; ++r) { const int kv = crow(r, hi); if (kv > qa) p0[r] = -INFINITY; if (kv + 32 > qa) p1[r] = -INFINITY; }
            }
            float mx = p0[0];
#pragma unroll
            for (int r = 1; r < 16; ++r) mx = fmaxf(mx, p0[r]);
#pragma unroll
            for (int r = 0; r < 16; ++r) mx = fmaxf(mx, p1[r]);
            mx = fmaxf(mx, __shfl_xor(mx, 32));
            const float mnew = fmaxf(mrun, mx), alpha = __builtin_amdgcn_exp2f(mrun - mnew);
            float rs = 0.f;
#pragma unroll
            for (int r = 0; r < 16; ++r) { p0[r] = __builtin_amdgcn_exp2f(p0[r] - mnew); p1[r] = __builtin_amdgcn_exp2f(p1[r] - mnew); rs += p0[r] + p1[r]; }
            lrun = lrun * alpha + rs; mrun = mnew;
#pragma unroll
            for (int d = 0; d < 4; ++d)
#pragma unroll
                for (int r = 0; r < 16; ++r) o[d][r] *= alpha;
            bf16x8 pf[4];
            { u32x4 w;
              w.x = pk2(p0[0], p0[1]); w.y = pk2(p0[2], p0[3]); w.z = pk2(p0[4], p0[5]); w.w = pk2(p0[6], p0[7]); pf[0] = __builtin_bit_cast(bf16x8, w);
              w.x = pk2(p0[8], p0[9]); w.y = pk2(p0[10], p0[11]); w.z = pk2(p0[12], p0[13]); w.w = pk2(p0[14], p0[15]); pf[1] = __builtin_bit_cast(bf16x8, w);
              w.x = pk2(p1[0], p1[1]); w.y = pk2(p1[2], p1[3]); w.z = pk2(p1[4], p1[5]); w.w = pk2(p1[6], p1[7]); pf[2] = __builtin_bit_cast(bf16x8, w);
              w.x = pk2(p1[8], p1[9]); w.y = pk2(p1[10], p1[11]); w.z = pk2(p1[12], p1[13]); w.w = pk2(p1[14], p1[15]); pf[3] = __builtin_bit_cast(bf16x8, w); }
#pragma unroll
            for (int d = 0; d < 4; ++d) {
                const LAS unsigned char* vp = lds + V_OFF + (32 * d + ql) * VROW + 8 * hi;
#pragma unroll
                for (int ks = 0; ks < 4; ++ks) {
                    const u32x2 lo = *(const LAS u32x2*)(vp + 32 * ks), hi2 = *(const LAS u32x2*)(vp + 32 * ks + 16);
                    const u32x4 vv = {lo.x, lo.y, hi2.x, hi2.y};
                    o[d] = MFMA32(__builtin_bit_cast(bf16x8, vv), pf[ks], o[d]);
                }
                asm volatile("" ::: "memory");
            }
        }
    }
#undef ATT_LOAD
    const float ltot = lrun + __shfl_xor(lrun, 32), inv = 1.f / ltot;
    bf16_t* Op = OUTA + ((size_t)b * SEQ + q0 + ql) * 1024 + h * DV;
#pragma unroll
    for (int d = 0; d < 4; ++d)
#pragma unroll
        for (int g = 0; g < 4; ++g) { const int dd = 32 * d + 8 * g + 4 * hi;
            u32x2 w; w.x = pk2(o[d][4 * g] * inv, o[d][4 * g + 1] * inv); w.y = pk2(o[d][4 * g + 2] * inv, o[d][4 * g + 3] * inv);
            *(u32x2*)(Op + dd) = w; }
    __syncthreads();
}
}

namespace ml {
constexpr int QROW = 272, VROW = 136, GROW = 144;
constexpr int Q_OFF = 0, K_OFF = 64 * QROW, KG_OFF = 2 * 64 * QROW, VT_OFF = KG_OFF + 128 * GROW, CT_OFF = VT_OFF + 128 * VROW, G_OFF = CT_OFF + 128 * QROW;
constexpr int GU = 0, GMM = 64, GA_ = 128, GEM = 192, GG = 256, GN = 320, GSS = 448, GSC = 704, G_FLOATS = 712;
constexpr int CWL_OFF = ((G_OFF + G_FLOATS * 4 + 255) / 256) * 256;
static_assert(CWL_OFF + 2 * 5 * 128 * 4 <= RING_BYTES, "mlstm lds");
using att::crow;
#define ML_FENCE() asm volatile("" ::: "memory")
__device__ __forceinline__ void item(int b, int h, const Args& args, LAS unsigned char* lds) {
    unsigned char* ws = args.ws;
    const bf16_t* MLQK = (const bf16_t*)(ws + WS_MLQK); const bf16_t* MLV = (const bf16_t*)(ws + WS_MLV); const bf16_t* SIGO = (const bf16_t*)(ws + WS_SIGO);
    const float* SM = (const float*)(ws + WS_SM); bf16_t* HM = (bf16_t*)(ws + WS_HM);
    const float* conv_w = (const float*)args.in[13]; const float* conv_b = (const float*)args.in[14]; const float* bg = (const float*)args.in[15]; const float* gnorm = (const float*)args.in[16];
    const int tid = threadIdx.x, lane = tid & 63, tl = lane & 31, hi = lane >> 5; const int wid = __builtin_amdgcn_readfirstlane(tid >> 6);
    const int et = wid & 3, tt = wid >> 2;
    LAS float* G = (LAS float*)(lds + G_OFF);
    LAS float* CWL = (LAS float*)(lds + CWL_OFF);
    for (int i = tid; i < 128 * QROW / 4; i += 512) ((LAS unsigned*)(lds + CT_OFF))[i] = 0u;
    if (tid < 128) G[GN + tid] = 0.f;
    for (int i = tid; i < 2 * 5 * 128; i += 512) { const int w2 = i / 640, j = (i % 640) / 128, c = i & 127; const int col = w2 * 1024 + h * 128 + c;
        CWL[i] = (j < 4) ? conv_w[j * 2048 + col] : conv_b[col]; }
    f32x16 cacc[2]; cacc[0] = f32x16{}; cacc[1] = f32x16{};
    float mstate = 0.f;
    const float bi = bg[h], bf_ = bg[8 + h];
    const int which = tid >> 8, tg = (tid >> 4) & 15, cc = tid & 15;
    const int ccol = which * 1024 + h * 128 + 8 * cc;
    const int vhw = tid >> 5, vsp = tid & 31;
    const size_t rowb = (size_t)b * SEQ;
    u32x4 craw[7], vraw[2]; float gi = 0.f, gf = 0.f;
#define ML_LOAD(ck) do { const int t0_ = (ck) * 64; \
        _Pragma("unroll") for (int i = 0; i < 7; ++i) { const int ts = t0_ + 4 * tg - 3 + i; craw[i] = (ts >= 0) ? *(const u32x4*)(MLQK + (rowb + ts) * 2048 + ccol) : (u32x4){0u, 0u, 0u, 0u}; } \
        vraw[0] = *(const u32x4*)(MLV + (rowb + t0_ + 2 * vsp) * 1024 + h * 128 + 8 * vhw); vraw[1] = *(const u32x4*)(MLV + (rowb + t0_ + 2 * vsp + 1) * 1024 + h * 128 + 8 * vhw); \
        if (wid == 0) { gi = SM[(rowb + t0_ + lane) * 256 + 64 + h]; gf = SM[(rowb + t0_ + lane) * 256 + 72 + h]; } } while (0)
    ML_LOAD(0);
    __syncthreads();
    for (int ck = 0; ck < 32; ++ck) {
        const int t0 = ck * 64;
        if (wid == 0) {
            const float fp = gf + bf_, ip = gi + bi;
            const float lf = fminf(fp, 0.f) - __logf(1.f + __expf(-fabsf(fp)));
            float bsum = lf;
#pragma unroll
            for (int o = 1; o < 64; o <<= 1) { const float v = __shfl_up(bsum, o); if (lane >= o) bsum += v; }
            const float u = ip - bsum;
            float M = u;
#pragma unroll
            for (int o = 1; o < 64; o <<= 1) { const float v = __shfl_up(M, o); if (lane >= o) M = fmaxf(M, v); }
            const float mm = fmaxf(M, mstate);
            const float mmL = __shfl(mm, 63), bL = __shfl(bsum, 63);
            G[GU + lane] = u; G[GMM + lane] = mm; G[GA_ + lane] = __expf(mstate - mm); G[GEM + lane] = __expf(-(bsum + mm)); G[GG + lane] = __expf(u - mmL);
            if (lane == 0) G[GSC] = __expf(mstate - mmL);
            mstate = bL + mmL;
        }
        __syncthreads();
        {
            const float ksc = (which == 0) ? 1.f : 0.08838834764831845f;
            float gs[4];
#pragma unroll
            for (int t = 0; t < 4; ++t) gs[t] = G[GG + 4 * tg + t];
            unsigned ow[4][4];
            const LAS float* cwp = CWL + which * 640 + 8 * cc;
#pragma unroll
            for (int w2 = 0; w2 < 4; ++w2) {
                float xa[7], xb[7];
#pragma unroll
                for (int i = 0; i < 7; ++i) { const unsigned wv = (w2 == 0) ? craw[i].x : (w2 == 1) ? craw[i].y : (w2 == 2) ? craw[i].z : craw[i].w; xa[i] = bflo(wv); xb[i] = bfhi(wv); }
                float ya[4], yb[4];
#pragma unroll
                for (int t = 0; t < 4; ++t) { float sa = cwp[4 * 128 + 2 * w2], sb = cwp[4 * 128 + 2 * w2 + 1];
#pragma unroll
                    for (int j = 0; j < 4; ++j) { sa += cwp[j * 128 + 2 * w2] * xa[t + j]; sb += cwp[j * 128 + 2 * w2 + 1] * xb[t + j]; }
                    ya[t] = sa * sigm(sa) * ksc; yb[t] = sb * sigm(sb) * ksc; ow[t][w2] = pk2(ya[t], yb[t]); }
                if (which == 1) {
                    u32x2 wa; wa.x = pk2(ya[0] * gs[0], ya[1] * gs[1]); wa.y = pk2(ya[2] * gs[2], ya[3] * gs[3]);
                    u32x2 wb; wb.x = pk2(yb[0] * gs[0], yb[1] * gs[1]); wb.y = pk2(yb[2] * gs[2], yb[3] * gs[3]);
                    *(LAS u32x2*)(lds + KG_OFF + (8 * cc + 2 * w2) * GROW + 8 * tg) = wa;
                    *(LAS u32x2*)(lds + KG_OFF + (8 * cc + 2 * w2 + 1) * GROW + 8 * tg) = wb;
                }
            }
            const int qk_off = (which == 0) ? Q_OFF : K_OFF;
#pragma unroll
            for (int t = 0; t < 4; ++t) { const u32x4 w = {ow[t][0], ow[t][1], ow[t][2], ow[t][3]}; *(LAS u32x4*)(lds + qk_off + (4 * tg + t) * QROW + 16 * cc) = w; }
            const unsigned a[4] = {vraw[0].x, vraw[0].y, vraw[0].z, vraw[0].w}, c2[4] = {vraw[1].x, vraw[1].y, vraw[1].z, vraw[1].w};
#pragma unroll
            for (int jj = 0; jj < 4; ++jj) {
                const unsigned lo = (a[jj] & 0xffffu) | (c2[jj] << 16), hi2 = (a[jj] >> 16) | (c2[jj] & 0xffff0000u);
                *(LAS unsigned*)(lds + VT_OFF + (8 * vhw + 2 * jj) * VROW + 4 * vsp) = lo;
                *(LAS unsigned*)(lds + VT_OFF + (8 * vhw + 2 * jj + 1) * VROW + 4 * vsp) = hi2;
            }
        }
        if (ck + 1 < 32) ML_LOAD(ck + 1);
        __syncthreads();
        const int t = 32 * tt + tl;
        const float mm_t = G[GMM + t], a_t = G[GA_ + t], em_t = G[GEM + t];
        f32x16 hacc = f32x16{};
        float den = 0.f;
        bf16x8 qf[8];
#pragma unroll
        for (int ks = 0; ks < 8; ++ks) qf[ks] = *(const LAS bf16x8*)(lds + Q_OFF + t * QROW + 32 * ks + 16 * hi);
        ML_FENCE();
#pragma unroll
        for (int st = 0; st < 2; ++st) {
            if (st <= tt) {
                f32x16 p = f32x16{};
#pragma unroll
                for (int ks = 0; ks < 8; ++ks) { const bf16x8 kf = *(const LAS bf16x8*)(lds + K_OFF + (32 * st + tl) * QROW + 32 * ks + 16 * hi); p = MFMA32(kf, qf[ks], p); if ((ks & 3) == 3) ML_FENCE(); }
#pragma unroll
                for (int r = 0; r < 16; ++r) { const int s = 32 * st + crow(r, hi); const float wv = (s <= t) ? __expf(G[GU + s] - mm_t) : 0.f; p[r] *= wv; den += p[r]; }
                bf16x8 pf[2];
                { u32x4 w;
                  w.x = pk2(p[0], p[1]); w.y = pk2(p[2], p[3]); w.z = pk2(p[4], p[5]); w.w = pk2(p[6], p[7]); pf[0] = __builtin_bit_cast(bf16x8, w);
                  w.x = pk2(p[8], p[9]); w.y = pk2(p[10], p[11]); w.z = pk2(p[12], p[13]); w.w = pk2(p[14], p[15]); pf[1] = __builtin_bit_cast(bf16x8, w); }
#pragma unroll
                for (int k2 = 0; k2 < 2; ++k2) {
                    const LAS unsigned char* vp = lds + VT_OFF + (32 * et + tl) * VROW + 32 * (2 * st + k2) + 8 * hi;
                    const u32x2 lo = *(const LAS u32x2*)(vp), hi2 = *(const LAS u32x2*)(vp + 16);
                    const u32x4 vv = {lo.x, lo.y, hi2.x, hi2.y};
                    hacc = MFMA32(__builtin_bit_cast(bf16x8, vv), pf[k2], hacc);
                }
                ML_FENCE();
            }
        }
        den += __shfl_xor(den, 32);
        f32x16 qc = f32x16{};
#pragma unroll
        for (int ks = 0; ks < 8; ++ks) { const bf16x8 cf = *(const LAS bf16x8*)(lds + CT_OFF + (32 * et + tl) * QROW + 32 * ks + 16 * hi); qc = MFMA32(cf, qf[ks], qc); if ((ks & 3) == 3) ML_FENCE(); }
        float dq = 0.f;
#pragma unroll
        for (int i = 0; i < 8; ++i) { const u32x4 qv = *(const LAS u32x4*)(lds + Q_OFF + t * QROW + 128 * hi + 16 * i); const LAS float* np = G + GN + 64 * hi + 8 * i;
            dq += bflo(qv.x) * np[0] + bfhi(qv.x) * np[1] + bflo(qv.y) * np[2] + bfhi(qv.y) * np[3] + bflo(qv.z) * np[4] + bfhi(qv.z) * np[5] + bflo(qv.w) * np[6] + bfhi(qv.w) * np[7];
            if ((i & 1) == 1) ML_FENCE(); }
        dq += __shfl_xor(dq, 32);
        den += a_t * dq;
        const float rden = 1.f / fmaxf(fabsf(den), em_t);
        float ssq = 0.f;
#pragma unroll
        for (int r = 0; r < 16; ++r) { hacc[r] = (hacc[r] + a_t * qc[r]) * rden; ssq += hacc[r] * hacc[r]; }
        ssq += __shfl_xor(ssq, 32);
        if (hi == 0) G[GSS + t * 4 + et] = ssq;
        const size_t orow = (rowb + t0 + t) * 1024 + h * 128 + 32 * et + 4 * hi;
        u32x2 sg[4];
#pragma unroll
        for (int g = 0; g < 4; ++g) sg[g] = *(const u32x2*)(SIGO + orow + 8 * g);
        const float decay = G[GSC];
        __syncthreads();
        {
            const float tot = G[GSS + t * 4] + G[GSS + t * 4 + 1] + G[GSS + t * 4 + 2] + G[GSS + t * 4 + 3];
            const float rstd = 1.f / sqrtf(tot * (1.f / 128.f) + EPS);
#pragma unroll
            for (int g = 0; g < 4; ++g) { const f32x4 gn = *(const f32x4*)(gnorm + h * 128 + 32 * et + 4 * hi + 8 * g); u32x2 w;
                w.x = pk2(hacc[4 * g] * rstd * gn[0] * bflo(sg[g].x), hacc[4 * g + 1] * rstd * gn[1] * bfhi(sg[g].x));
                w.y = pk2(hacc[4 * g + 2] * rstd * gn[2] * bflo(sg[g].y), hacc[4 * g + 3] * rstd * gn[3] * bfhi(sg[g].y));
                *(u32x2*)(HM + orow + 8 * g) = w; }
        }
        ML_FENCE();
#pragma unroll
        for (int i = 0; i < 2; ++i) {
#pragma unroll
            for (int r = 0; r < 16; ++r) cacc[i][r] *= decay;
#pragma unroll
            for (int ks = 0; ks < 4; ++ks) {
                const LAS unsigned char* vp = lds + VT_OFF + (32 * et + tl) * VROW + 32 * ks + 16 * hi;
                const u32x2 lo = *(const LAS u32x2*)(vp), hi2 = *(const LAS u32x2*)(vp + 8);
                const u32x4 vv = {lo.x, lo.y, hi2.x, hi2.y};
                const bf16x8 kg = *(const LAS bf16x8*)(lds + KG_OFF + (32 * (2 * tt + i) + tl) * GROW + 32 * ks + 16 * hi);
                cacc[i] = MFMA32(__builtin_bit_cast(bf16x8, vv), kg, cacc[i]);
            }
#pragma unroll
            for (int r = 0; r < 16; ++r) *(LAS bf16_t*)(lds + CT_OFF + (32 * et + crow(r, hi)) * QROW + 2 * (32 * (2 * tt + i) + tl)) = (bf16_t)f2bf(cacc[i][r]);
            ML_FENCE();
        }
        if (tid < 128) { float s = 0.f;
#pragma unroll
            for (int i = 0; i < 8; ++i) { const u32x4 kv = *(const LAS u32x4*)(lds + KG_OFF + tid * GROW + 16 * i);
                s += bflo(kv.x) + bfhi(kv.x) + bflo(kv.y) + bfhi(kv.y) + bflo(kv.z) + bfhi(kv.z) + bflo(kv.w) + bfhi(kv.w); }
            G[GN + tid] = decay * G[GN + tid] + s; }
    }
#undef ML_LOAD
    __syncthreads();
}
}

__global__ void __launch_bounds__(NWAVES * 64, 2) mk_fwd(Args args) {
    extern __shared__ __attribute__((aligned(16))) unsigned char lds_raw[];
    LAS unsigned char* lds = (LAS unsigned char*)lds_raw;
    volatile LAS unsigned* MISC = (volatile LAS unsigned*)(lds + MISC_OFF);
    const int tid = threadIdx.x, lane = tid & 63, wave = __builtin_amdgcn_readfirstlane(tid >> 6);
    const int G = gridDim.x; const int bx = blockIdx.x; const int vcu = (G % 8 == 0) ? (bx % 8) * (G / 8) + bx / 8 : bx;
    unsigned char* ws = args.ws;
    gu32* ctl = (gu32*)(ws + WS_CTL);
    for (int u = tid; u < (LDS_BYTES - LDSCTL_OFF) / 4; u += NWAVES * 64) ((LAS unsigned*)(lds + LDSCTL_OFF))[u] = 0u;
    __syncthreads();
    XcdBarrier bar; bar.bar = (unsigned*)(ctl + CW_BAR); bar.x = 0; bar.st = nullptr;
    if (MK_N_LAUNCHES != PER_PHASE) bar = xcd_barrier_post((unsigned*)(ctl + CW_BAR), MISC + 8);
#define GRID_BAR() do { if (MK_N_LAUNCHES != PER_PHASE) xcd_barrier(bar); } while (0)
    const int lo = args.ph_lo, hi = args.ph_hi;
#ifndef PH_MASK
#define PH_MASK 0xfff
#endif
#define IN(k) (((PH_MASK >> (k)) & 1) && lo <= (k) && (k) < hi)
#define BOTH(k) (IN(k) && IN((k) + 1))
    const int gw = vcu * NWAVES + wave, NGW = G * NWAVES;
    float* MOD = (float*)(ws + WS_MOD);

    if (IN(0)) {
        const float* c_in = (const float*)args.in[1]; const float* w_ada = (const float*)args.in[3]; const float* b_ada = (const float*)args.in[4];
        if (bx < 192) {
            LAS float* scond = (LAS float*)lds; LAS float* part = (LAS float*)(lds + 32768);
            for (int i = tid; i < NB * DM; i += 512) { const float v = c_in[i]; scond[i] = v * sigm(v); }
            __syncthreads();
            const int n0 = 64 * bx, rs = lane >> 4, c4 = lane & 15;
            f32x4 a0 = {0.f, 0.f, 0.f, 0.f}, a1 = a0, a2 = a0, a3 = a0;
#pragma unroll 8
            for (int it = 0; it < 64; ++it) { const int k = 256 * wave + 4 * it + rs; const f32x4 wv = *(const f32x4*)(w_ada + (size_t)k * 12288 + n0 + 4 * c4);
                a0 += wv * scond[k]; a1 += wv * scond[2048 + k]; a2 += wv * scond[4096 + k]; a3 += wv * scond[6144 + k]; }
#pragma unroll
            for (int j = 0; j < 4; ++j) { a0[j] += __shfl_xor(a0[j], 16); a0[j] += __shfl_xor(a0[j], 32); a1[j] += __shfl_xor(a1[j], 16); a1[j] += __shfl_xor(a1[j], 32);
                a2[j] += __shfl_xor(a2[j], 16); a2[j] += __shfl_xor(a2[j], 32); a3[j] += __shfl_xor(a3[j], 16); a3[j] += __shfl_xor(a3[j], 32); }
            if (rs == 0) { *(LAS f32x4*)(part + (wave * 4 + 0) * 64 + 4 * c4) = a0; *(LAS f32x4*)(part + (wave * 4 + 1) * 64 + 4 * c4) = a1;
                *(LAS f32x4*)(part + (wave * 4 + 2) * 64 + 4 * c4) = a2; *(LAS f32x4*)(part + (wave * 4 + 3) * 64 + 4 * c4) = a3; }
            __syncthreads();
            if (tid < 256) { const int b = tid >> 6, col = tid & 63; float s = b_ada[n0 + col];
#pragma unroll
                for (int w = 0; w < 8; ++w) s += part[(w * 4 + b) * 64 + col];
                MOD[b * 12288 + n0 + col] = s; }
            __syncthreads();
        }
        LAS float* scr = (LAS float*)(lds + wave * 16384);
        const float* w_in = (const float*)args.in[6]; const float* w_uq = (const float*)args.in[8]; const float* w_ukv = (const float*)args.in[10];
        const float* w_pa = (const float*)args.in[17]; const float* w_pb = (const float*)args.in[18]; const float* w_out = (const float*)args.in[19];
        const float* w_ge = (const float*)args.in[25]; const float* w_ue = (const float*)args.in[26]; const float* w_de = (const float*)args.in[27];
        const float* qag = (const float*)args.in[7]; const float* kvag = (const float*)args.in[9];
        constexpr int I_IN = 32 * 283, I_UQ = 8 * 48, I_UKV = 4 * 64, I_P = 16 * 64, I_O = 32 * 64, I_G = 32 * 16, I_D = 8 * 64;
        constexpr int NITEMS = I_IN + I_UQ + I_UKV + 2 * I_P + I_O + 32 * (2 * I_G + I_D);
        for (int it = gw; it < NITEMS; it += NGW) {
            int r = it;
            if (r < I_IN) { p0_transpose_item(w_in, DM, INC, (bf16_t*)(ws + WS_WIN), scr, r, lane, nullptr, RmWin{}); continue; } r -= I_IN;
            if (r < I_UQ) { p0_transpose_item(w_uq, QL, 1536, (bf16_t*)(ws + WS_WUQ), scr, r, lane, qag, RmId{}); continue; } r -= I_UQ;
            if (r < I_UKV) { p0_transpose_item(w_ukv, KVL, 2048, (bf16_t*)(ws + WS_WUKV), scr, r, lane, kvag, RmId{}); continue; } r -= I_UKV;
            if (r < I_P) { p0_transpose_item(w_pa, 1024, DM, (bf16_t*)(ws + WS_WPA), scr, r, lane, nullptr, RmId{}); continue; } r -= I_P;
            if (r < I_P) { p0_transpose_item(w_pb, 1024, DM, (bf16_t*)(ws + WS_WPB), scr, r, lane, nullptr, RmId{}); continue; } r -= I_P;
            if (r < I_O) { p0_transpose_item(w_out, DM, DM, (bf16_t*)(ws + WS_WOUT), scr, r, lane, nullptr, RmId{}); continue; } r -= I_O;
            const int e = r / (2 * I_G + I_D); r -= e * (2 * I_G + I_D);
            if (r < I_G) { p0_transpose_item(w_ge + (size_t)e * DM * DFF, DM, DFF, (bf16_t*)(ws + WS_WGU), scr, r, lane, nullptr, RmGate{e * 1024}); continue; } r -= I_G;
            if (r < I_G) { p0_transpose_item(w_ue + (size_t)e * DM * DFF, DM, DFF, (bf16_t*)(ws + WS_WGU), scr, r, lane, nullptr, RmGate{e * 1024 + 128}); continue; } r -= I_G;
            p0_transpose_item(w_de + (size_t)e * DFF * DM, DFF, DM, (bf16_t*)(ws + WS_WD) + (size_t)e * DM * DFF, scr, r, lane, nullptr, RmId{});
        }
        { u32x4* z = (u32x4*)(ws + WS_WIN + (size_t)848 * DM * 2); const int n16 = 176 * DM * 2 / 16;
          for (int i = gw * 64 + lane; i < n16; i += NGW * 64) z[i] = (u32x4){0u, 0u, 0u, 0u}; }
        if (BOTH(0)) GRID_BAR();
    }

    if (IN(1)) {
        const float* x = (const float*)args.in[0]; const float* g = (const float*)args.in[5]; bf16_t* H = (bf16_t*)(ws + WS_H);
        for (int m = gw; m < MTOK; m += NGW) {
            const int b = m >> 11; const f32x4* xr = (const f32x4*)(x + (size_t)m * DM) + lane;
            f32x4 v[8]; float s = 0.f;
#pragma unroll
            for (int j = 0; j < 8; ++j) { v[j] = xr[64 * j]; s += (v[j][0] * v[j][0] + v[j][1] * v[j][1]) + (v[j][2] * v[j][2] + v[j][3] * v[j][3]); }
            const float rstd = 1.f / sqrtf(wave_sum(s) * (1.f / DM) + EPS);
            unsigned long long* o8 = (unsigned long long*)(H + (size_t)m * DM) + lane;
#pragma unroll
            for (int j = 0; j < 8; ++j) { const int k = 4 * (lane + 64 * j); const f32x4 gv = *(const f32x4*)(g + k), sh = *(const f32x4*)(MOD + b * 12288 + k), sc = *(const f32x4*)(MOD + b * 12288 + 2048 + k);
                const f32x4 hv = v[j] * rstd * gv * (sc + 1.f) + sh;
                o8[64 * j] = (unsigned long long)pk2(hv[0], hv[1]) | ((unsigned long long)pk2(hv[2], hv[3]) << 32); }
        }
        if (BOTH(1)) GRID_BAR();
    }

    if (IN(2)) {
        pg8::StaticSched S; S.T.init(MTOK, INCP, G, bx); S.A = (const char*)(ws + WS_H); S.B = (const char*)(ws + WS_WIN); S.K = DM;
        pg8::EpiProj E{ws};
        pg8::gemm_phase<pg8::EpiProj, pg8::StaticSched, false>(lds, DM, S, E);
        if (BOTH(2)) GRID_BAR();
    }

    if (IN(3)) {
        { pg8::StaticSched S; S.T.init(MTOK, 1536, G, bx); S.A = (const char*)(ws + WS_CQ); S.B = (const char*)(ws + WS_WUQ); S.K = QL;
          pg8::EpiBf16 E{(bf16_t*)(ws + WS_QRAW), 1536};
          pg8::gemm_phase<pg8::EpiBf16, pg8::StaticSched, false>(lds, QL, S, E); }
        { pg8::StaticSched S; S.T.init(MTOK, 2048, G, bx); S.A = (const char*)(ws + WS_CKV); S.B = (const char*)(ws + WS_WUKV); S.K = KVL;
          pg8::EpiBf16 E{(bf16_t*)(ws + WS_KVRAW), 2048};
          pg8::gemm_phase<pg8::EpiBf16, pg8::StaticSched, false>(lds, KVL, S, E); }
        if (BOTH(3)) GRID_BAR();
    }

    if (IN(4)) {
        const bf16_t* CQ = (const bf16_t*)(ws + WS_CQ); const bf16_t* CKV = (const bf16_t*)(ws + WS_CKV); const float* SM = (const float*)(ws + WS_SM);
        const bf16_t* QRAW = (const bf16_t*)(ws + WS_QRAW); const bf16_t* KVRAW = (const bf16_t*)(ws + WS_KVRAW);
        bf16_t* Qo = (bf16_t*)(ws + WS_Q); bf16_t* Ko = (bf16_t*)(ws + WS_K); bf16_t* Vo = (bf16_t*)(ws + WS_V);
        const int* pos = (const int*)args.in[2]; const float* gq = (const float*)args.in[11]; const float* gk = (const float*)args.in[12];
        const float gq0 = gq[lane], gq1 = gq[lane + 64], gq2 = gq[lane + 128], gk0 = gk[lane], gk1 = gk[lane + 64], gk2 = gk[lane + 128];
        const float invf = args.inv_freq[lane & 31];
        for (int tok = gw; tok < MTOK; tok += NGW) {
            const int b = tok >> 11, s = tok & 2047;
            float scq, sckv;
            { const u32x4 w = *(const u32x4*)(CQ + (size_t)tok * QL + 8 * lane); float a = 0.f; a += bflo(w.x) * bflo(w.x) + bfhi(w.x) * bfhi(w.x); a += bflo(w.y) * bflo(w.y) + bfhi(w.y) * bfhi(w.y);
              a += bflo(w.z) * bflo(w.z) + bfhi(w.z) * bfhi(w.z); a += bflo(w.w) * bflo(w.w) + bfhi(w.w) * bfhi(w.w); scq = 1.f / sqrtf(wave_sum(a) * (1.f / QL) + EPS); }
            { const u32x2 w = *(const u32x2*)(CKV + (size_t)tok * KVL + 4 * lane); float a = bflo(w.x) * bflo(w.x) + bfhi(w.x) * bfhi(w.x) + bflo(w.y) * bflo(w.y) + bfhi(w.y) * bfhi(w.y);
              sckv = 1.f / sqrtf(wave_sum(a) * (1.f / KVL) + EPS); }
            const float kpe = SM[(size_t)tok * 256 + lane];
            float cs, sn;
            { const float ang = (float)pos[tok] * invf; const float n = rintf(ang * 0.15915494309189535f);
              float r = fmaf(-n, 6.28125f, ang); r = fmaf(-n, C2PI_2, r); r = fmaf(-n, C2PI_3, r);
              const float rev = r * 0.15915494309189535f; cs = __builtin_amdgcn_cosf(rev); sn = __builtin_amdgcn_sinf(rev); }
            const float kpe2 = kpe * kpe;
#pragma unroll 2
            for (int h = 0; h < NH; ++h) {
                const bf16_t* qr = QRAW + (size_t)tok * 1536 + h * DQK; const bf16_t* kr = KVRAW + (size_t)tok * 2048 + h * 256;
                const float x0 = bf1(qr[lane]), x1 = bf1(qr[lane + 64]), x2 = bf1(qr[lane + 128]);
                const float k0 = bf1(kr[lane]), k1 = bf1(kr[lane + 64]), v0 = bf1(kr[128 + lane]), v1 = bf1(kr[192 + lane]);
                const float sq = wave_sum(x0 * x0 + x1 * x1 + x2 * x2), sk = wave_sum(sckv * sckv * (k0 * k0 + k1 * k1) + kpe2);
                const float rq = scq / sqrtf(scq * scq * sq * (1.f / DQK) + EPS) * QSCALE, rk = 1.f / sqrtf(sk * (1.f / DQK) + EPS);
                const float y0 = x0 * rq * gq0, y1 = x1 * rq * gq1, y2 = x2 * rq * gq2;
                const float z0 = k0 * sckv * rk * gk0, z1 = k1 * sckv * rk * gk1, z2 = kpe * rk * gk2;
                const float py = __shfl_xor(y2, 32), pz = __shfl_xor(z2, 32);
                const float yr = (lane < 32) ? (y2 * cs - py * sn) : (py * sn + y2 * cs), zr = (lane < 32) ? (z2 * cs - pz * sn) : (pz * sn + z2 * cs);
                const size_t bhs = ((size_t)(b * NH + h) * SEQ + s);
                bf16_t* qo = Qo + bhs * DQK; bf16_t* ko = Ko + bhs * DQK; bf16_t* vo = Vo + bhs * DV;
                qo[lane] = (bf16_t)f2bf(y0); qo[lane + 64] = (bf16_t)f2bf(y1); qo[lane + 128] = (bf16_t)f2bf(yr);
                ko[lane] = (bf16_t)f2bf(z0); ko[lane + 64] = (bf16_t)f2bf(z1); ko[lane + 128] = (bf16_t)f2bf(zr);
                vo[lane] = (bf16_t)f2bf(v0 * sckv); vo[lane + 64] = (bf16_t)f2bf(v1 * sckv);
            }
        }
        if (BOTH(4)) GRID_BAR();
    }

    if (IN(5)) {
#ifndef NO_ML
        if (bx < 32) {
            ml::item(bx >> 3, bx & 7, args, lds);
        } else
#endif
#ifndef NO_ATT
        {
            LAS int* qslot = (LAS int*)(lds + MISC_OFF + 64);
            for (;;) {
                __syncthreads();
                if (tid == 0) *qslot = (int)__hip_atomic_fetch_add(ctl + CW_ATTQ, 1u, RLX_AGENT);
                __syncthreads();
                const int it = *qslot;
                if (it >= 256) break;
                const int qb = 7 - (it >> 5), bh = it & 31;
                att::unit(bh >> 3, bh & 7, qb, (const bf16_t*)(ws + WS_Q), (const bf16_t*)(ws + WS_K), (const bf16_t*)(ws + WS_V), (bf16_t*)(ws + WS_OUTA), lds);
            }
        }
#else
        {}
#endif
        if (BOTH(5)) GRID_BAR();
    }

    if (IN(6)) {
        pg8::ChainSched S; S.T.init(MTOK, DM, G, bx); S.A0 = (const char*)(ws + WS_OUTA); S.B0 = (const char*)(ws + WS_WPA); S.A1 = (const char*)(ws + WS_HM); S.B1 = (const char*)(ws + WS_WPB); S.K = 1024;
        pg8::EpiMix E{(const bf16_t*)(ws + WS_GA), (const bf16_t*)(ws + WS_GB), (bf16_t*)(ws + WS_MIXED)};
        pg8::gemm_phase<pg8::EpiMix, pg8::ChainSched, false, true>(lds, 1024, S, E);
        if (BOTH(6)) GRID_BAR();
    }

    if (IN(7)) {
        pg8::StaticSched S; S.T.init(MTOK, DM, G, bx); S.A = (const char*)(ws + WS_MIXED); S.B = (const char*)(ws + WS_WOUT); S.K = DM;
        pg8::EpiOut E{(const float*)args.in[0], MOD, args.out};
        pg8::gemm_phase<pg8::EpiOut, pg8::StaticSched, false>(lds, DM, S, E);
        if (BOTH(7)) GRID_BAR();
    }

    if (IN(8)) {
        const float* g2 = (const float*)args.in[20]; const float* wg = (const float*)args.in[21]; const float* bgp = (const float*)args.in[22];
        const float* wrt = (const float*)args.in[23]; const float* brt = (const float*)args.in[24];
        bf16_t* H2 = (bf16_t*)(ws + WS_H); int* tokinfo = (int*)(ws + WS_TOKINFO); int* tokof = (int*)(ws + WS_TOKOF); float* combof = (float*)(ws + WS_COMBOF);
        for (int m = gw; m < MTOK; m += NGW) {
            const int b = m >> 11; const f32x4* xr = (const f32x4*)(args.out + (size_t)m * DM) + lane;
            f32x4 v[8]; float s = 0.f;
#pragma unroll
            for (int j = 0; j < 8; ++j) { v[j] = xr[64 * j]; s += (v[j][0] * v[j][0] + v[j][1] * v[j][1]) + (v[j][2] * v[j][2] + v[j][3] * v[j][3]); }
            const float rstd = 1.f / sqrtf(wave_sum(s) * (1.f / DM) + EPS);
            unsigned long long* o8 = (unsigned long long*)(H2 + (size_t)m * DM) + lane;
            float lg[36];
#pragma unroll
            for (int i = 0; i < 36; ++i) lg[i] = 0.f;
#pragma unroll
            for (int j = 0; j < 8; ++j) { const int k = 4 * (lane + 64 * j); const f32x4 gv = *(const f32x4*)(g2 + k), sh = *(const f32x4*)(MOD + b * 12288 + 6144 + k), sc = *(const f32x4*)(MOD + b * 12288 + 8192 + k);
                const f32x4 hv = v[j] * rstd * gv * (sc + 1.f) + sh;
                o8[64 * j] = (unsigned long long)pk2(hv[0], hv[1]) | ((unsigned long long)pk2(hv[2], hv[3]) << 32);
#pragma unroll
                for (int c = 0; c < 4; ++c) { const f32x4 w4 = *(const f32x4*)(wg + (size_t)(k + c) * 4);
                    lg[0] += hv[c] * w4[0]; lg[1] += hv[c] * w4[1]; lg[2] += hv[c] * w4[2]; lg[3] += hv[c] * w4[3];
#pragma unroll
                    for (int q = 0; q < 8; ++q) { const f32x4 wr4 = *(const f32x4*)(wrt + (size_t)(k + c) * 32 + 4 * q);
                        lg[4 + 4 * q] += hv[c] * wr4[0]; lg[5 + 4 * q] += hv[c] * wr4[1]; lg[6 + 4 * q] += hv[c] * wr4[2]; lg[7 + 4 * q] += hv[c] * wr4[3]; } } }
#pragma unroll
            for (int i = 0; i < 36; ++i) lg[i] = wave_sum(lg[i]);
            if (lane == 0) {
                float gl[4]; int gs = 0;
#pragma unroll
                for (int i = 0; i < 4; ++i) gl[i] = lg[i] + bgp[i];
                float gmx = gl[0];
#pragma unroll
                for (int i = 1; i < 4; ++i) if (gl[i] > gmx) { gmx = gl[i]; gs = i; }
                float gsum = 0.f;
#pragma unroll
                for (int i = 0; i < 4; ++i) gsum += __expf(gl[i] - gmx);
                const float gwt = 1.f / gsum;
                float el[8];
#pragma unroll
                for (int i = 0; i < 8; ++i) { float a = lg[4 + i] + brt[i];
                    a = (gs == 1) ? lg[12 + i] + brt[8 + i] : a; a = (gs == 2) ? lg[20 + i] + brt[16 + i] : a; a = (gs == 3) ? lg[28 + i] + brt[24 + i] : a; el[i] = a; }
                int i0 = 0; float m0 = el[0];
#pragma unroll
                for (int i = 1; i < 8; ++i) if (el[i] > m0) { m0 = el[i]; i0 = i; }
                int i1 = -1; float m1 = -INFINITY;
#pragma unroll
                for (int i = 0; i < 8; ++i) if (i != i0 && el[i] > m1) { m1 = el[i]; i1 = i; }
                const float p1 = __expf(m1 - m0), w0 = gwt / (1.f + p1), w1 = gwt * p1 / (1.f + p1);
                const int e0 = gs * 8 + i0, e1 = gs * 8 + i1;
                const int pos0 = (int)__hip_atomic_fetch_add(ctl + CW_CNT + e0, 1u, RLX_AGENT), pos1 = (int)__hip_atomic_fetch_add(ctl + CW_CNT + e1, 1u, RLX_AGENT);
                tokof[e0 * 8192 + pos0] = m; combof[e0 * 8192 + pos0] = w0; tokof[e1 * 8192 + pos1] = m; combof[e1 * 8192 + pos1] = w1;
                tokinfo[m * 4 + 0] = e0; tokinfo[m * 4 + 1] = pos0; tokinfo[m * 4 + 2] = e1; tokinfo[m * 4 + 3] = pos1;
            }
        }
        if (BOTH(8)) GRID_BAR();
    }

    LAS int* tstart = (LAS int*)(lds + MISC_OFF + 128); LAS int* ecnt = (LAS int*)(lds + MISC_OFF + 128 + 33 * 4 + 12);
    if (IN(9) || IN(10) || IN(11)) {
        __syncthreads();
        if (tid == 0) { int acc = 0; for (int e = 0; e < 32; ++e) { const int c = (int)__hip_atomic_load(ctl + CW_CNT + e, RLX_AGENT); ecnt[e] = c; tstart[e] = acc; acc += (c + 255) >> 8; } tstart[32] = acc; }
        __syncthreads();
    }

    if (IN(9)) {
        pg8::MoeUpSched S{tstart, ecnt, (const int*)(ws + WS_TOKOF), (const char*)(ws + WS_H), (const char*)(ws + WS_WGU), G, bx};
        pg8::EpiMoeUp E{(const float*)(ws + WS_COMBOF), (bf16_t*)(ws + WS_ACT)};
        pg8::gemm_phase<pg8::EpiMoeUp, pg8::MoeUpSched, true>(lds, DM, S, E);
        if (BOTH(9)) GRID_BAR();
    }

    if (IN(10)) {
        pg8::MoeDownSched S{tstart, (const char*)(ws + WS_ACT), (const char*)(ws + WS_WD), G, bx};
        pg8::EpiBf16 E{(bf16_t*)(ws + WS_Y), DM};
        pg8::gemm_phase<pg8::EpiBf16, pg8::MoeDownSched, false>(lds, DFF, S, E);
        if (BOTH(10)) GRID_BAR();
    }

    if (IN(11)) {
        const bf16_t* Y = (const bf16_t*)(ws + WS_Y); const int* tokinfo = (const int*)(ws + WS_TOKINFO);
        for (int m = gw; m < MTOK; m += NGW) {
            const int b = m >> 11;
            const int e0 = tokinfo[m * 4], p0 = tokinfo[m * 4 + 1], e1 = tokinfo[m * 4 + 2], p1 = tokinfo[m * 4 + 3];
            const size_t s0 = (size_t)tstart[e0] * 256 + p0, s1 = (size_t)tstart[e1] * 256 + p1;
            f32x4* xr = (f32x4*)(args.out + (size_t)m * DM) + lane;
            const u32x2* y0 = (const u32x2*)(Y + s0 * DM) + lane; const u32x2* y1 = (const u32x2*)(Y + s1 * DM) + lane;
#pragma unroll
            for (int j = 0; j < 8; ++j) { const int k = 4 * (lane + 64 * j); const f32x4 gt = *(const f32x4*)(MOD + b * 12288 + 10240 + k);
                const u32x2 a = y0[64 * j], c = y1[64 * j]; const f32x4 xv = xr[64 * j];
                const f32x4 mo = {bflo(a.x) + bflo(c.x), bfhi(a.x) + bfhi(c.x), bflo(a.y) + bflo(c.y), bfhi(a.y) + bfhi(c.y)};
                xr[64 * j] = xv + gt * mo; }
        }
    }
#undef IN
#undef BOTH
#undef GRID_BAR
}

extern "C" void kernel_launch(void* const* d_in, const int* in_sizes, int n_in, void* d_out, int out_size, void* d_ws, size_t ws_size, hipStream_t stream) {
    static int grid = 0;
    if (grid == 0) {
        if (n_in != 28 || in_sizes[0] != MTOK * DM || out_size != MTOK * DM || ws_size < WS_END) {
            fprintf(stderr, "kernel_launch: unexpected shapes (n_in %d in0 %d out %d ws %zu need %zu)\n", n_in, n_in > 0 ? in_sizes[0] : -1, out_size, ws_size, (size_t)WS_END); grid = -1; return; }
        int dev = 0, cus = 0, per_cu = 0;
        if (hipGetDevice(&dev) != hipSuccess || hipDeviceGetAttribute(&cus, hipDeviceAttributeMultiprocessorCount, dev) != hipSuccess) { grid = -1; return; }
        if (hipFuncSetAttribute((const void*)mk_fwd, hipFuncAttributeMaxDynamicSharedMemorySize, LDS_BYTES) != hipSuccess) { fprintf(stderr, "kernel_launch: hipFuncSetAttribute failed\n"); grid = -1; return; }
        if (hipOccupancyMaxActiveBlocksPerMultiprocessor(&per_cu, (const void*)mk_fwd, NWAVES * 64, LDS_BYTES) != hipSuccess || per_cu < 1)
            fprintf(stderr, "kernel_launch: occupancy query reports %d blocks per CU\n", per_cu);
        (void)hipGetLastError();
        grid = cus;
    }
    if (grid < 0) return;
    (void)hipMemsetAsync((char*)d_ws + WS_CTL, 0, CTL_ZERO_BYTES, stream);
    Args a{};
    for (int i = 0; i < 28; ++i) a.in[i] = d_in[i];
    a.out = (float*)d_out; a.ws = (unsigned char*)d_ws;
    for (int i = 0; i < 32; ++i) a.inv_freq[i] = (float)pow(10000.0, -(double)(2 * i) / 64.0);
#if MK_N_LAUNCHES == 1
    a.ph_lo = 0; a.ph_hi = PER_PHASE; a.li = 0;
    hipLaunchKernelGGL(mk_fwd, dim3(grid), dim3(NWAVES * 64), LDS_BYTES, stream, a);
#else
    for (int li = 0; li < PER_PHASE; ++li) { a.ph_lo = li; a.ph_hi = li + 1; a.li = li;
        hipLaunchKernelGGL(mk_fwd, dim3(grid), dim3(NWAVES * 64), LDS_BYTES, stream, a); }
#endif
}
```

```cpp
#include <hip/hip_runtime.h>
#include <hip/hip_bf16.h>
#include <cstdio>
#include <cstdint>
#include <cmath>

#ifndef MK_N_LAUNCHES
#define MK_N_LAUNCHES 1
#endif

#define LAS __attribute__((address_space(3)))
#define GAS __attribute__((address_space(1)))
typedef unsigned short bf16_t;
typedef short bf16x8 __attribute__((ext_vector_type(8)));
typedef short s16x4 __attribute__((ext_vector_type(4)));
typedef float f32x4 __attribute__((ext_vector_type(4)));
typedef float f32x2 __attribute__((ext_vector_type(2)));
typedef float f32x16 __attribute__((ext_vector_type(16)));
typedef unsigned u32x4 __attribute__((ext_vector_type(4)));
typedef unsigned u32x2 __attribute__((ext_vector_type(2)));
typedef __bf16 bf16x2_t __attribute__((ext_vector_type(2)));
typedef GAS unsigned gu32;

constexpr int DM = 2048, NB = 4, SEQ = 2048, MTOK = NB * SEQ;
constexpr int NH = 8, DQK = 192, DNOPE = 128, DROPE = 64, DV = 128;
constexpr int QL = 512, KVL = 256;
constexpr int INC = 9040, INCP = 9216;
constexpr int NE = 32, DFF = 512;
constexpr float EPS = 1e-6f;
constexpr int SLOT_CAP = 24576;
constexpr float QSCALE = 0.07216878364870322f * 1.4426950408889634f;
constexpr float C2PI_2 = 0.0019353071693331003f, C2PI_3 = 1.0253131677018246e-11f;

constexpr size_t MiB = 1u << 20;
constexpr size_t WS_CTL = 0, CTL_ZERO_BYTES = 1 * MiB;
constexpr size_t WS_MOD = 1 * MiB;
constexpr size_t WS_CVEC = WS_MOD + 200 * 1024;
constexpr size_t WS_GS2 = WS_MOD + 208 * 1024;
constexpr size_t WS_WRT = WS_MOD + 256 * 1024;
constexpr size_t WS_WUQ = 2 * MiB;
constexpr size_t WS_WUKV = 4 * MiB;
constexpr size_t WS_TOKINFO = 5 * MiB;
constexpr size_t WS_TOKOF = 6 * MiB;
constexpr size_t WS_COMBOF = 7 * MiB;
constexpr size_t WS_WIN = 8 * MiB;
constexpr size_t WS_WPA = 44 * MiB, WS_WPB = 48 * MiB, WS_WOUT = 52 * MiB;
constexpr size_t WS_WGU = 60 * MiB;
constexpr size_t WS_WD = 188 * MiB;
constexpr size_t WS_H = 252 * MiB;
constexpr size_t WS_CQ = 284 * MiB, WS_CKV = 292 * MiB, WS_SM = 296 * MiB;
constexpr size_t WS_MLQK = 304 * MiB, WS_MLV = 336 * MiB, WS_SIGO = 352 * MiB, WS_GA = 368 * MiB, WS_GB = 400 * MiB;
constexpr size_t WS_Y = 304 * MiB;
constexpr size_t WS_ACT = 400 * MiB;
constexpr size_t WS_QRAW = 432 * MiB, WS_KVRAW = 456 * MiB;
constexpr size_t WS_MIXED = 432 * MiB;
constexpr size_t WS_Q = 488 * MiB, WS_K = 512 * MiB, WS_V = 536 * MiB;
constexpr size_t WS_OUTA = 552 * MiB, WS_HM = 568 * MiB;
constexpr size_t WS_END = 584 * MiB;

constexpr int CW_TMO = 0;
constexpr int CW_CNT = 1024;
constexpr int CW_ATTQ = 2048;
constexpr int CW_BAR = 4096;

constexpr int RING_BYTES = 131072;
constexpr int LDSCTL_OFF = RING_BYTES, MISC_OFF = LDSCTL_OFF + 320;
constexpr int LDS_BYTES = 147456;
constexpr int NWAVES = 8;

#define RLX_AGENT __ATOMIC_RELAXED, __HIP_MEMORY_SCOPE_AGENT
#define LDS_WAIT() asm volatile("s_waitcnt lgkmcnt(0)" ::: "memory")
#define VM_WAIT() asm volatile("s_waitcnt vmcnt(0)" ::: "memory")

__device__ __forceinline__ unsigned f2bf(float f) { unsigned u = __builtin_bit_cast(unsigned, f); return (u + 0x7fffu + ((u >> 16) & 1u)) >> 16; }
__device__ __forceinline__ unsigned pk2(float lo, float hi) { f32x2 v = {lo, hi}; bf16x2_t b = __builtin_convertvector(v, bf16x2_t); return __builtin_bit_cast(unsigned, b); }
__device__ __forceinline__ float bflo(unsigned w) { return __builtin_bit_cast(float, w << 16); }
__device__ __forceinline__ float bfhi(unsigned w) { return __builtin_bit_cast(float, w & 0xffff0000u); }
__device__ __forceinline__ float bf1(bf16_t h) { return __builtin_bit_cast(float, (unsigned)h << 16); }
__device__ __forceinline__ float sigm(float x) { return __builtin_amdgcn_rcpf(1.f + __expf(-x)); }
__device__ __forceinline__ int fresh_tid() { int t = threadIdx.x; asm volatile("" : "+v"(t)); return t; }
__device__ __forceinline__ float wave_sum(float v) {
#pragma unroll
    for (int o = 1; o < 64; o <<= 1) v += __shfl_xor(v, o);
    return v;
}

namespace pg8 {
constexpr int BM = 256, BK = 64, HALF = 128, HTB = HALF * BK * 2, STAGE_BYTES = 8 * HTB, NXCD = 8, WGM = 8;
__host__ __device__ __forceinline__ int lds_byte(int r, int c) { const int st = (r >> 4) * 2 + (c >> 5), rr = r & 15, cc = c & 31, ob = rr * 64 + cc * 2; return st * 1024 + (ob ^ (((ob >> 9) & 1) << 5)); }
__host__ __device__ __forceinline__ void stage_rc(int b, int& R, int& C) { const int st = b / 1024, sb = b % 1024, swz = sb ^ (((sb >> 9) & 1) << 5); R = (st >> 1) * 16 + swz / 64; C = (st & 1) * 32 + (swz % 64) / 2; }
__host__ __device__ __forceinline__ int perm32(int rho) { const int n = rho >> 4, i = rho & 15; return 8 * (i >> 2) + 4 * n + (i & 3); }

struct Unit { const char* A; const char* B; const char* A2; const char* B2; int pm, pn, e, r0, cnt; };

struct TileOrder {
    int nM, nN, nwg, G, c;
    __device__ __forceinline__ void init(int M, int N, int G_, int c_) { nM = M / BM; nN = N / BM; nwg = nM * nN; G = G_; c = c_; }
    __device__ __forceinline__ bool tile(int i, int& pm, int& pn) const {
        const long L = (long)i * G + c; if (L >= nwg) return false;
        int wgid = (int)L; { const int q = nwg / NXCD, r = nwg % NXCD, xcd = wgid % NXCD, off = wgid / NXCD; wgid = (xcd < r ? xcd * (q + 1) : r * (q + 1) + (xcd - r) * q) + off; }
        const int nig = WGM * nN, gid = wgid / nig, fm = gid * WGM, gsz = (nM - fm) < WGM ? (nM - fm) : WGM;
        pm = fm + ((wgid % nig) % gsz); pn = (wgid % nig) / gsz; return true;
    }
};
struct StaticSched {
    TileOrder T; const char* A; const char* B; int K;
    __device__ __forceinline__ bool next(int i, Unit& u) const { int pm, pn; if (!T.tile(i, pm, pn)) return false; u.pm = pm; u.pn = pn; u.e = 0; u.r0 = 0; u.cnt = 0;
        u.A = A + (size_t)pm * BM * K * 2; u.B = B + (size_t)pn * BM * K * 2; u.A2 = u.A; u.B2 = u.B; return true; }
    __device__ __forceinline__ int tok(const Unit&, int r) const { return r; }
};
struct ChainSched {
    TileOrder T; const char* A0; const char* B0; const char* A1; const char* B1; int K;
    __device__ __forceinline__ bool next(int i, Unit& u) const { int pm, pn; if (!T.tile(i, pm, pn)) return false; u.pm = pm; u.pn = pn; u.e = 0; u.r0 = 0; u.cnt = 0;
        u.A = A0 + (size_t)pm * BM * K * 2; u.B = B0 + (size_t)pn * BM * K * 2; u.A2 = A1 + (size_t)pm * BM * K * 2; u.B2 = B1 + (size_t)pn * BM * K * 2; return true; }
    __device__ __forceinline__ int tok(const Unit&, int r) const { return r; }
};
struct MoeUpSched {
    const LAS int* tstart; const LAS int* cnt; const int* tokof; const char* A; const char* B; int G, c;
    __device__ __forceinline__ bool next(int i, Unit& u) const {
        const int L = i * G + c, ntot = tstart[32] * 4; if (L >= ntot) return false;
        const int T = L >> 2; int e = 0;
        for (int j = 1; j < 32; ++j) e = (T >= tstart[j]) ? j : e;
        e = __builtin_amdgcn_readfirstlane(e);
        const int mt = T - tstart[e];
        u.pm = T; u.pn = L & 3; u.e = e; u.r0 = mt * 256; u.cnt = cnt[e];
        u.A = A; u.B = B + ((size_t)e * 1024 + (size_t)u.pn * 256) * 2048 * 2; u.A2 = u.A; u.B2 = u.B; return true; }
    __device__ __forceinline__ int tok(const Unit& u, int r) const { const int rr = u.r0 + r; return tokof[u.e * 8192 + (rr < u.cnt ? rr : u.r0)]; }
};
struct MoeDownSched {
    const LAS int* tstart; const char* A; const char* B; int G, c;
    __device__ __forceinline__ bool next(int i, Unit& u) const {
        const int L = i * G + c, ntot = tstart[32] * 8; if (L >= ntot) return false;
        const int T = L >> 3; int e = 0;
        for (int j = 1; j < 32; ++j) e = (T >= tstart[j]) ? j : e;
        e = __builtin_amdgcn_readfirstlane(e);
        u.pm = T; u.pn = L & 7; u.e = e; u.r0 = 0; u.cnt = 0;
        u.A = A + (size_t)T * 256 * 512 * 2; u.B = B + ((size_t)e * 2048 + (size_t)u.pn * 256) * 512 * 2; u.A2 = u.A; u.B2 = u.B; return true; }
    __device__ __forceinline__ int tok(const Unit&, int r) const { return r; }
};

template <class Epi, class Sched, bool GATHER, bool CHAIN = false>
__device__ __forceinline__ void gemm_phase(LAS unsigned char* lds, const int K, const Sched& S, const Epi& E) {
    const int tid = fresh_tid(), wid = __builtin_amdgcn_readfirstlane(tid >> 6), lane = tid & 63, wr = wid >> 2, wc = wid & 3, fr = lane & 15, fq = lane >> 4;
    const int nt = K / BK;
    int sR[2], sC[2]; unsigned voffB[2];
#pragma unroll
    for (int i = 0; i < 2; ++i) { int R, C; stage_rc(tid * 16 + i * 8192, R, C); sR[i] = R; sC[i] = C; const int Rb = Epi::PERM ? ((R & ~31) + perm32(R & 31)) : R; voffB[i] = (unsigned)(Rb * K + C) * 2u; }
    const size_t kstep = (size_t)(BK * 2);
    const size_t hstep = (size_t)HALF * K * 2;
    const unsigned ldsw = (unsigned)wid * 1024u;
    const int aoff = lds_byte(wr * 64 + fr, fq * 8), boff = lds_byte(wc * 32 + fr, fq * 8);
#define PG8_SA(b, h) (((b) * 2 + (h)) * HTB)
#define PG8_SB(b, h) ((4 + (b) * 2 + (h)) * HTB)
#define PG8_STAGE(bufoff, gbase, voff) do { _Pragma("unroll") for (int _i = 0; _i < 2; ++_i) \
        __builtin_amdgcn_global_load_lds((const unsigned*)((const char*)(gbase) + (voff)[_i]), (LAS unsigned*)(lds + (bufoff) + ldsw + _i * 8192), 16, 0, 0); } while (0)
#define PG8_LDA(dst, b, h) do { _Pragma("unroll") for (int m = 0; m < 4; ++m) _Pragma("unroll") for (int k = 0; k < 2; ++k) dst[m][k] = *(const LAS bf16x8*)(lds + PG8_SA(b, h) + aoff + m * 2048 + k * 1024); } while (0)
#define PG8_LDB(dst, b, h) do { _Pragma("unroll") for (int n = 0; n < 2; ++n) _Pragma("unroll") for (int k = 0; k < 2; ++k) dst[n][k] = *(const LAS bf16x8*)(lds + PG8_SB(b, h) + boff + n * 2048 + k * 1024); } while (0)
#define PG8_MMA(ai, bj, At, Bt) do { __builtin_amdgcn_s_setprio(1); _Pragma("unroll") for (int m = 0; m < 4; ++m) _Pragma("unroll") for (int n = 0; n < 2; ++n) _Pragma("unroll") for (int k = 0; k < 2; ++k) \
        acc[ai][bj][m][n] = __builtin_amdgcn_mfma_f32_16x16x32_bf16(Bt[n][k], At[m][k], acc[ai][bj][m][n], 0, 0, 0); __builtin_amdgcn_s_setprio(0); } while (0)
#define PG8_WAIT_V(n) asm volatile("s_waitcnt vmcnt(" #n ")" ::: "memory")
#define PG8_WAIT_L(n) asm volatile("s_waitcnt lgkmcnt(" #n ")" ::: "memory")
#define PG8_BAR __builtin_amdgcn_s_barrier()
#define PG8_SCHED __builtin_amdgcn_sched_barrier(0)
#define PG8_OFFS(dst, unit) do { _Pragma("unroll") for (int _h = 0; _h < 2; ++_h) _Pragma("unroll") for (int _i = 0; _i < 2; ++_i) { \
        const int _row = GATHER ? S.tok(unit, _h * HALF + sR[_i]) : (_h * HALF + sR[_i]); dst[_h][_i] = (unsigned)(_row * K + sC[_i]) * 2u; } } while (0)
#define PG8_KLOOP(cA_, cB_, nA_, nB_, useN_) do { \
        for (int t = 0; t < nt; t += 2) { \
            const bool last = (t == nt - 2); \
            const char* a1 = (cA_) + (size_t)(t + 1) * kstep; \
            const char* a2 = last ? (nA_) : (cA_) + (size_t)(t + 2) * kstep; const char* b2 = last ? (nB_) : (cB_) + (size_t)(t + 2) * kstep; \
            const char* a3 = a2 + kstep; const char* b3 = b2 + kstep; \
            unsigned o2[2][2]; \
_Pragma("unroll") \
            for (int h = 0; h < 2; ++h) \
_Pragma("unroll") \
                for (int i = 0; i < 2; ++i) o2[h][i] = (GATHER && last && (useN_)) ? voN[h][i] : voA[h][i]; \
            PG8_LDB(B0, 0, 0); PG8_LDB(B1, 0, 1); PG8_SCHED; PG8_LDA(At, 0, 0); PG8_STAGE(PG8_SA(1, 1), a1, voA[1]); \
            PG8_WAIT_V(8); PG8_WAIT_L(0); PG8_BAR; PG8_MMA(0, 0, At, B0); PG8_MMA(0, 1, At, B1); PG8_BAR; PG8_SCHED; \
            PG8_LDA(At, 0, 1); PG8_STAGE(PG8_SB(0, 0), b2, voffB); PG8_STAGE(PG8_SB(0, 1), b2 + hstep, voffB); PG8_STAGE(PG8_SA(0, 0), a2, o2[0]); \
            PG8_WAIT_V(8); PG8_WAIT_L(0); PG8_BAR; PG8_MMA(1, 0, At, B0); PG8_MMA(1, 1, At, B1); PG8_BAR; PG8_SCHED; \
            PG8_LDB(B0, 1, 0); PG8_LDB(B1, 1, 1); PG8_SCHED; PG8_LDA(At, 1, 0); PG8_STAGE(PG8_SA(0, 1), a2, o2[1]); \
            PG8_WAIT_V(8); PG8_WAIT_L(0); PG8_BAR; PG8_MMA(0, 0, At, B0); PG8_MMA(0, 1, At, B1); PG8_BAR; PG8_SCHED; \
            PG8_LDA(At, 1, 1); PG8_STAGE(PG8_SB(1, 0), b3, voffB); PG8_STAGE(PG8_SB(1, 1), b3 + hstep, voffB); PG8_STAGE(PG8_SA(1, 0), a3, o2[0]); \
            PG8_WAIT_V(8); PG8_WAIT_L(0); PG8_BAR; PG8_MMA(1, 0, At, B0); PG8_MMA(1, 1, At, B1); PG8_BAR; PG8_SCHED; \
        } \
    } while (0)
    Unit cur, nxt; int ui = 0;
    if (!S.next(0, cur)) return;
    f32x4 acc[2][2][4][2];
#pragma unroll
    for (int a = 0; a < 2; ++a)
#pragma unroll
        for (int b = 0; b < 2; ++b)
#pragma unroll
            for (int m = 0; m < 4; ++m)
#pragma unroll
                for (int n = 0; n < 2; ++n) acc[a][b][m][n] = (f32x4){0.f, 0.f, 0.f, 0.f};
    bf16x8 At[4][2], B0[2][2], B1[2][2];
    unsigned voA[2][2], voN[2][2];
    PG8_OFFS(voA, cur);
    const char* cA = cur.A; const char* cB = cur.B;
    PG8_STAGE(PG8_SB(0, 0), cB, voffB); PG8_STAGE(PG8_SB(0, 1), cB + hstep, voffB); PG8_STAGE(PG8_SA(0, 0), cA, voA[0]); PG8_STAGE(PG8_SA(0, 1), cA, voA[1]);
    if (wr == 1) PG8_BAR;
    PG8_WAIT_V(2); PG8_BAR;
    PG8_STAGE(PG8_SB(1, 0), cB + kstep, voffB); PG8_STAGE(PG8_SA(1, 0), cA + kstep, voA[0]); PG8_STAGE(PG8_SB(1, 1), cB + hstep + kstep, voffB);
    PG8_WAIT_V(6); PG8_BAR;
    for (;;) {
        const bool has_next = S.next(ui + 1, nxt);
        const char* nA = has_next ? nxt.A : cA; const char* nB = has_next ? nxt.B : cB;
        if (GATHER) { if (has_next) { PG8_OFFS(voN, nxt); } else {
#pragma unroll
            for (int h = 0; h < 2; ++h)
#pragma unroll
                for (int i = 0; i < 2; ++i) voN[h][i] = voA[h][i]; } }
        if constexpr (CHAIN) { PG8_KLOOP(cA, cB, cur.A2, cur.B2, false); E.mid(acc, cur, wr, wc, fr, fq); PG8_KLOOP(cur.A2, cur.B2, nA, nB, true); }
        else { PG8_KLOOP(cA, cB, nA, nB, true); }
        if (wr == 0) PG8_BAR;
        E(acc, cur, wr, wc, fr, fq);
        if (!has_next) break;
        {
#pragma unroll
            for (int a = 0; a < 2; ++a)
#pragma unroll
                for (int b = 0; b < 2; ++b)
#pragma unroll
                    for (int m = 0; m < 4; ++m)
#pragma unroll
                        for (int n = 0; n < 2; ++n) acc[a][b][m][n] = (f32x4){0.f, 0.f, 0.f, 0.f};
        }
        cur = nxt; cA = nA; cB = nB; ++ui;
        if (GATHER) {
#pragma unroll
            for (int h = 0; h < 2; ++h)
#pragma unroll
                for (int i = 0; i < 2; ++i) voA[h][i] = voN[h][i]; }
        if (wr == 1) PG8_BAR;
    }
    PG8_WAIT_V(0);
    PG8_BAR;
#undef PG8_SA
#undef PG8_SB
#undef PG8_STAGE
#undef PG8_LDA
#undef PG8_LDB
#undef PG8_MMA
#undef PG8_WAIT_V
#undef PG8_WAIT_L
#undef PG8_BAR
#undef PG8_SCHED
#undef PG8_OFFS
#undef PG8_KLOOP
}

struct EpiBf16 {
    static constexpr bool PERM = true;
    bf16_t* O; int ldc;
    __device__ __forceinline__ void mid(f32x4 (&)[2][2][4][2], const Unit&, int, int, int, int) const {}
    __device__ __forceinline__ void operator()(const f32x4 (&acc)[2][2][4][2], const Unit& u, int wr, int wc, int fr, int fq) const {
        const int row0 = u.pm * BM + wr * 64 + fr, col0 = u.pn * BM + wc * 32 + 8 * fq;
#pragma unroll
        for (int ai = 0; ai < 2; ++ai)
#pragma unroll
            for (int m = 0; m < 4; ++m) { bf16_t* rowp = O + (size_t)(row0 + ai * HALF + m * 16) * ldc + col0;
#pragma unroll
                for (int bj = 0; bj < 2; ++bj) { const f32x4 v0 = acc[ai][bj][m][0], v1 = acc[ai][bj][m][1];
                    u32x4 w; w.x = pk2(v0[0], v0[1]); w.y = pk2(v0[2], v0[3]); w.z = pk2(v1[0], v1[1]); w.w = pk2(v1[2], v1[3]);
                    *(u32x4*)(rowp + bj * HALF) = w; } }
    }
};
struct EpiProj {
    static constexpr bool PERM = true;
    unsigned char* ws;
    __device__ __forceinline__ void mid(f32x4 (&)[2][2][4][2], const Unit&, int, int, int, int) const {}
    __device__ __forceinline__ void operator()(const f32x4 (&acc)[2][2][4][2], const Unit& u, int wr, int wc, int fr, int fq) const {
        const int pn = u.pn; size_t boff; int ldc, colt, mode = 0;
        if (pn < 2) { boff = WS_CQ; ldc = 512; colt = pn * 256; }
        else if (pn == 2) { boff = WS_CKV; ldc = 256; colt = 0; }
        else if (pn == 3) { boff = WS_SM; ldc = 256; colt = 0; mode = 2; }
        else if (pn < 12) { boff = WS_MLQK; ldc = 2048; colt = (pn - 4) * 256; }
        else if (pn < 16) { boff = WS_MLV; ldc = 1024; colt = (pn - 12) * 256; }
        else if (pn < 20) { boff = WS_SIGO; ldc = 1024; colt = (pn - 16) * 256; mode = 1; }
        else if (pn < 28) { boff = WS_GA; ldc = 2048; colt = (pn - 20) * 256; mode = 1; }
        else { boff = WS_GB; ldc = 2048; colt = (pn - 28) * 256; mode = 1; }
        const int row0 = u.pm * BM + wr * 64 + fr, col0 = colt + wc * 32 + 8 * fq;
        if (mode == 2) {
            float* O = (float*)(ws + boff);
#pragma unroll
            for (int ai = 0; ai < 2; ++ai)
#pragma unroll
                for (int m = 0; m < 4; ++m) { float* rowp = O + (size_t)(row0 + ai * HALF + m * 16) * ldc + col0;
#pragma unroll
                    for (int bj = 0; bj < 2; ++bj) { *(f32x4*)(rowp + bj * HALF) = acc[ai][bj][m][0]; *(f32x4*)(rowp + bj * HALF + 4) = acc[ai][bj][m][1]; } }
        } else {
            bf16_t* O = (bf16_t*)(ws + boff);
#pragma unroll
            for (int ai = 0; ai < 2; ++ai)
#pragma unroll
                for (int m = 0; m < 4; ++m) { bf16_t* rowp = O + (size_t)(row0 + ai * HALF + m * 16) * ldc + col0;
#pragma unroll
                    for (int bj = 0; bj < 2; ++bj) { f32x4 v0 = acc[ai][bj][m][0], v1 = acc[ai][bj][m][1];
                        if (mode == 1) { v0 = (f32x4){sigm(v0[0]), sigm(v0[1]), sigm(v0[2]), sigm(v0[3])}; v1 = (f32x4){sigm(v1[0]), sigm(v1[1]), sigm(v1[2]), sigm(v1[3])}; }
                        u32x4 w; w.x = pk2(v0[0], v0[1]); w.y = pk2(v0[2], v0[3]); w.z = pk2(v1[0], v1[1]); w.w = pk2(v1[2], v1[3]);
                        *(u32x4*)(rowp + bj * HALF) = w; } }
        }
    }
};
struct EpiMix {
    static constexpr bool PERM = true;
    const bf16_t* GA; const bf16_t* GB; bf16_t* O;
    __device__ __forceinline__ void mid(f32x4 (&acc)[2][2][4][2], const Unit& u, int wr, int wc, int fr, int fq) const {
        const int row0 = u.pm * BM + wr * 64 + fr, col0 = u.pn * BM + wc * 32 + 8 * fq;
#pragma unroll
        for (int ai = 0; ai < 2; ++ai)
#pragma unroll
            for (int m = 0; m < 4; ++m) { const size_t off = (size_t)(row0 + ai * HALF + m * 16) * DM + col0;
#pragma unroll
                for (int bj = 0; bj < 2; ++bj) { const u32x4 a = *(const u32x4*)(GA + off + bj * HALF), b = *(const u32x4*)(GB + off + bj * HALF);
                    f32x4 r0 = {bflo(a.x) * __builtin_amdgcn_rcpf(bflo(b.x)), bfhi(a.x) * __builtin_amdgcn_rcpf(bfhi(b.x)), bflo(a.y) * __builtin_amdgcn_rcpf(bflo(b.y)), bfhi(a.y) * __builtin_amdgcn_rcpf(bfhi(b.y))};
                    f32x4 r1 = {bflo(a.z) * __builtin_amdgcn_rcpf(bflo(b.z)), bfhi(a.z) * __builtin_amdgcn_rcpf(bfhi(b.z)), bflo(a.w) * __builtin_amdgcn_rcpf(bflo(b.w)), bfhi(a.w) * __builtin_amdgcn_rcpf(bfhi(b.w))};
                    acc[ai][bj][m][0] = acc[ai][bj][m][0] * r0; acc[ai][bj][m][1] = acc[ai][bj][m][1] * r1;
                    asm volatile("" : "+v"(acc[ai][bj][m][0]), "+v"(acc[ai][bj][m][1]) :: "memory"); } }
    }
    __device__ __forceinline__ void operator()(const f32x4 (&acc)[2][2][4][2], const Unit& u, int wr, int wc, int fr, int fq) const {
        int row0 = u.pm * BM + wr * 64 + fr, col0 = u.pn * BM + wc * 32 + 8 * fq;
        asm volatile("" : "+v"(row0), "+v"(col0));
#pragma unroll
        for (int ai = 0; ai < 2; ++ai)
#pragma unroll
            for (int m = 0; m < 4; ++m) { const size_t off = (size_t)(row0 + ai * HALF + m * 16) * DM + col0;
#pragma unroll
                for (int bj = 0; bj < 2; ++bj) { const u32x4 b = *(const u32x4*)(GB + off + bj * HALF);
                    const f32x4 v0 = acc[ai][bj][m][0], v1 = acc[ai][bj][m][1];
                    u32x4 w; w.x = pk2(v0[0] * bflo(b.x), v0[1] * bfhi(b.x)); w.y = pk2(v0[2] * bflo(b.y), v0[3] * bfhi(b.y));
                    w.z = pk2(v1[0] * bflo(b.z), v1[1] * bfhi(b.z)); w.w = pk2(v1[2] * bflo(b.w), v1[3] * bfhi(b.w));
                    *(u32x4*)(O + off + bj * HALF) = w; }
                asm volatile("" ::: "memory"); }
    }
};
struct EpiOut {
    static constexpr bool PERM = false;
    const float* X; const float* mod; float* O;
    __device__ __forceinline__ void mid(f32x4 (&)[2][2][4][2], const Unit&, int, int, int, int) const {}
    __device__ __forceinline__ void operator()(const f32x4 (&acc)[2][2][4][2], const Unit& u, int wr, int wc, int fr, int fq) const {
        const int row0 = u.pm * BM + wr * 64 + fr, col0 = u.pn * BM + wc * 32 + 4 * fq;
        const float* gt = mod + (size_t)(u.pm >> 3) * 12288 + 4096 + col0;
        f32x4 gv[2][2];
#pragma unroll
        for (int bj = 0; bj < 2; ++bj)
#pragma unroll
            for (int n = 0; n < 2; ++n) gv[bj][n] = *(const f32x4*)(gt + bj * HALF + n * 16);
#pragma unroll
        for (int ai = 0; ai < 2; ++ai)
#pragma unroll
            for (int m = 0; m < 4; ++m) { const size_t off = (size_t)(row0 + ai * HALF + m * 16) * DM + col0;
#pragma unroll
                for (int bj = 0; bj < 2; ++bj)
#pragma unroll
                    for (int n = 0; n < 2; ++n) { const f32x4 xv = *(const f32x4*)(X + off + bj * HALF + n * 16);
                        *(f32x4*)(O + off + bj * HALF + n * 16) = xv + gv[bj][n] * acc[ai][bj][m][n]; } }
    }
};
struct EpiMoeUp {
    static constexpr bool PERM = true;
    const float* combof; bf16_t* ACT;
    __device__ __forceinline__ void mid(f32x4 (&)[2][2][4][2], const Unit&, int, int, int, int) const {}
    __device__ __forceinline__ void operator()(const f32x4 (&acc)[2][2][4][2], const Unit& u, int wr, int wc, int fr, int fq) const {
        const int col0 = u.pn * HALF + wc * 32 + 8 * fq;
#pragma unroll
        for (int ai = 0; ai < 2; ++ai)
#pragma unroll
            for (int m = 0; m < 4; ++m) { const int r = ai * HALF + wr * 64 + m * 16 + fr; const int rr = u.r0 + r;
                const float cb = (rr < u.cnt) ? combof[u.e * 8192 + rr] : 0.f;
                const f32x4 g0 = acc[ai][0][m][0], g1 = acc[ai][0][m][1], u0 = acc[ai][1][m][0], u1 = acc[ai][1][m][1];
                u32x4 w;
                w.x = pk2(g0[0] * sigm(g0[0]) * u0[0] * cb, g0[1] * sigm(g0[1]) * u0[1] * cb); w.y = pk2(g0[2] * sigm(g0[2]) * u0[2] * cb, g0[3] * sigm(g0[3]) * u0[3] * cb);
                w.z = pk2(g1[0] * sigm(g1[0]) * u1[0] * cb, g1[1] * sigm(g1[1]) * u1[1] * cb); w.w = pk2(g1[2] * sigm(g1[2]) * u1[2] * cb, g1[3] * sigm(g1[3]) * u1[3] * cb);
                *(u32x4*)(ACT + (size_t)(u.pm * BM + r) * DFF + col0) = w; }
    }
};
}

#define XB_TMO      128
#define XB_XCNT(j)  (256  + 64 * (j))
#define XB_XSUB(j)  (1280 + 64 * (j))
#define XB_XGEN(j)  (2304 + 64 * (j))
#define XB_TOP      3328
#define XB_TOPGEN   3392
#define XCD_BAR_WORDS 3456
#define XB_SPIN_CAP (1u << 18)
__device__ __forceinline__ unsigned xb_ld(unsigned* p)              { return __hip_atomic_load(p, __ATOMIC_RELAXED, __HIP_MEMORY_SCOPE_AGENT); }
__device__ __forceinline__ unsigned xb_add(unsigned* p, unsigned v) { return __hip_atomic_fetch_add(p, v, __ATOMIC_RELAXED, __HIP_MEMORY_SCOPE_AGENT); }
__device__ __forceinline__ unsigned xb_xcc_id() { return (unsigned)__builtin_amdgcn_s_getreg((3 << 11) | 20) & 0xFu; }
#define XB_SPIN(cond, bar) do { unsigned _sp = 0; while (cond) { __builtin_amdgcn_s_sleep(1); \
    if ((++_sp & 255u) == 0u) { if (xb_ld(&(bar)[XB_TMO])) break; if (_sp > XB_SPIN_CAP) { atomicAdd(&(bar)[XB_TMO], 1u); break; } } } } while (0)
struct XcdBarrier { unsigned* bar; unsigned x; volatile LAS unsigned* st; };
__device__ __forceinline__ XcdBarrier xcd_barrier_post(unsigned* bar, volatile LAS unsigned* st) {
    XcdBarrier b; b.bar = bar; b.x = xb_xcc_id(); b.st = st;
    if (threadIdx.x == 0) (void)xb_add(&bar[XB_XCNT(b.x)], 1u);
    return b;
}
__device__ __forceinline__ void xcd_barrier_complete(unsigned* bar, unsigned x, unsigned& nloc, unsigned& nx) {
    const unsigned G = gridDim.x * gridDim.y * gridDim.z;
    unsigned sum, cnt, mine, sp = 0u;
    for (;;) {
        sum = 0u; cnt = 0u; mine = 0u;
#pragma unroll
        for (unsigned j = 0; j < 16; ++j) { const unsigned c = xb_ld(&bar[XB_XCNT(j)]); sum += c; cnt += (c > 0u) ? 1u : 0u; mine = (j == x) ? c : mine; }
        if (sum == G) break;
        __builtin_amdgcn_s_sleep(1);
        if ((++sp & 255u) == 0u) { if (xb_ld(&bar[XB_TMO])) break; if (sp > XB_SPIN_CAP) { atomicAdd(&bar[XB_TMO], 1u); break; } }
    }
    nloc = mine > 0u ? mine : 1u; nx = cnt > 0u ? cnt : 1u;
}
__device__ __forceinline__ void xcd_barrier(const XcdBarrier& b) {
    asm volatile("s_waitcnt vmcnt(0)" ::: "memory");
    __syncthreads();
    if (threadIdx.x == 0) {
        unsigned* bar = b.bar;
        __builtin_amdgcn_s_waitcnt(0);
        unsigned nloc = b.st[0], nx = b.st[1];
        if (nloc == 0u) { xcd_barrier_complete(bar, b.x, nloc, nx); b.st[0] = nloc; b.st[1] = nx; }
        const unsigned old = xb_add(&bar[XB_XSUB(b.x)], 1u);
        const unsigned gen = old / nloc;
        if (old + 1u == (gen + 1u) * nloc) {
            __builtin_amdgcn_fence(__ATOMIC_RELEASE, "agent");
            asm volatile("s_waitcnt vmcnt(0)" ::: "memory");
            const unsigned og = xb_add(&bar[XB_TOP], 1u);
            const unsigned tg = og / nx;
            if (og + 1u == (tg + 1u) * nx) xb_add(&bar[XB_TOPGEN], 1u);
            else XB_SPIN(xb_ld(&bar[XB_TOPGEN]) == tg, bar);
            __builtin_amdgcn_fence(__ATOMIC_ACQUIRE, "agent");
            xb_add(&bar[XB_XGEN(b.x)], 1u);
            asm volatile("s_waitcnt vmcnt(0)" ::: "memory");
        } else {
            XB_SPIN(xb_ld(&bar[XB_XGEN(b.x)]) == gen, bar);
            __builtin_amdgcn_fence(__ATOMIC_ACQUIRE, "agent");
            asm volatile("s_waitcnt vmcnt(0)" ::: "memory");
        }
    }
    __syncthreads();
}

struct Args { const void* in[28]; float* out; unsigned char* ws; float inv_freq[32]; int ph_lo, ph_hi, li, pad; };
constexpr int PER_PHASE = 12;

template <class RowMap>
__device__ __forceinline__ void p0_transpose_item(const float* W, int K, int N, bf16_t* WT, LAS float* scr, int item, int lane, const float* kscale, const RowMap& rm) {
    const int nblk = (N + 31) / 32, kb = item / nblk, nb = item % nblk, k0 = 64 * kb, n0 = 32 * nb;
    const int ncol = n0 + (lane & 31);
#pragma unroll 8
    for (int i = 0; i < 32; ++i) { const int kk = 2 * i + (lane >> 5); float v = 0.f; if (ncol < N) { v = W[(size_t)(k0 + kk) * N + ncol]; if (kscale) v *= kscale[k0 + kk]; } scr[kk * 33 + (lane & 31)] = v; }
    LDS_WAIT(); asm volatile("" ::: "memory");
    const int c = lane & 7;
#pragma unroll
    for (int j = 0; j < 4; ++j) { const int n = (lane >> 3) + 8 * j; const LAS float* s = scr + (8 * c) * 33 + n;
        u32x4 o; o.x = pk2(s[0 * 33], s[1 * 33]); o.y = pk2(s[2 * 33], s[3 * 33]); o.z = pk2(s[4 * 33], s[5 * 33]); o.w = pk2(s[6 * 33], s[7 * 33]);
        if (n0 + n < N) *(GAS u32x4*)(WT + (size_t)rm(n0 + n) * K + k0 + 8 * c) = o; }
    LDS_WAIT(); asm volatile("" ::: "memory");
}
struct RmId { __device__ __forceinline__ int operator()(int n) const { return n; } };
struct RmWin { __device__ __forceinline__ int operator()(int n) const {
    if (n < 832) return n; if (n < 2880) return 1024 + (n - 832); if (n < 3904) return 3072 + (n - 2880); if (n < 4928) return 4096 + (n - 3904);
    if (n < 4936) return 832 + (n - 4928); if (n < 4944) return 840 + (n - 4936); if (n < 6992) return 5120 + (n - 4944); return 7168 + (n - 6992); } };
struct RmGate { int base; __device__ __forceinline__ int operator()(int f) const { return base + (f >> 7) * 256 + (f & 127); } };

namespace att {
constexpr int KROW = 400, VROW = 136, K_OFF = 0, V_OFF = 64 * KROW;
__device__ __forceinline__ int crow(int r, int hi) { return (r & 3) + 8 * (r >> 2) + 4 * hi; }
#define MFMA32(a, b, c) __builtin_amdgcn_mfma_f32_32x32x16_bf16((a), (b), (c), 0, 0, 0)
__device__ __forceinline__ void unit(int b, int h, int qb, const bf16_t* Q, const bf16_t* Kg, const bf16_t* Vg, bf16_t* OUTA, LAS unsigned char* lds) {
    const int tid = fresh_tid(), lane = tid & 63, ql = lane & 31, hi = lane >> 5; const int wid = __builtin_amdgcn_readfirstlane(tid >> 6);
    const size_t bh = (size_t)(b * NH + h);
    const int q0 = qb * 256 + wid * 32;
    const bf16_t* Qp = Q + (bh * SEQ + q0 + ql) * DQK;
    bf16x8 qf[12];
#pragma unroll
    for (int s = 0; s < 12; ++s) qf[s] = *(const bf16x8*)(Qp + 16 * s + 8 * hi);
    f32x16 o[4];
#pragma unroll
    for (int d = 0; d < 4; ++d) o[d] = f32x16{};
    float mrun = -1e30f, lrun = 0.f;
    const int ntile = 4 * qb + 4;
    const bf16_t* Kb = Kg + bh * SEQ * DQK; const bf16_t* Vb = Vg + bh * SEQ * DV;
    const int vhw = tid >> 5, vsp = tid & 31;
    u32x4 kreg[3], vreg[2];
#define ATT_LOAD(j) do { _Pragma("unroll") for (int i = 0; i < 3; ++i) kreg[i] = *(const u32x4*)(Kb + (size_t)(j) * 64 * DQK + (size_t)(tid + 512 * i) * 8); \
        vreg[0] = *(const u32x4*)(Vb + ((size_t)(j) * 64 + 2 * vsp) * DV + 8 * vhw); vreg[1] = *(const u32x4*)(Vb + ((size_t)(j) * 64 + 2 * vsp + 1) * DV + 8 * vhw); } while (0)
    ATT_LOAD(0);
    for (int j = 0; j < ntile; ++j) {
        __syncthreads();
#pragma unroll
        for (int i = 0; i < 3; ++i) { const int p = tid + 512 * i, row = p / 24, c = p % 24; *(LAS u32x4*)(lds + K_OFF + row * KROW + 16 * c) = kreg[i]; }
        {
            const unsigned a[4] = {vreg[0].x, vreg[0].y, vreg[0].z, vreg[0].w}, c2[4] = {vreg[1].x, vreg[1].y, vreg[1].z, vreg[1].w};
#pragma unroll
            for (int jj = 0; jj < 4; ++jj) {
                const unsigned lo = (a[jj] & 0xffffu) | (c2[jj] << 16), hi2 = (a[jj] >> 16) | (c2[jj] & 0xffff0000u);
                *(LAS unsigned*)(lds + V_OFF + (8 * vhw + 2 * jj) * VROW + 4 * vsp) = lo;
                *(LAS unsigned*)(lds + V_OFF + (8 * vhw + 2 * jj + 1) * VROW + 4 * vsp) = hi2;
            }
        }
        __syncthreads();
        if (j + 1 < ntile) ATT_LOAD(j + 1);
        if (64 * j <= q0 + 31) {
            f32x16 p0 = f32x16{}, p1 = f32x16{};
            const LAS unsigned char* kp = lds + K_OFF + ql * KROW + 16 * hi;
#pragma unroll
            for (int s = 0; s < 12; ++s) {
                const bf16x8 k0 = *(const LAS bf16x8*)(kp + 32 * s), k1 = *(const LAS bf16x8*)(kp + 32 * KROW + 32 * s);
                p0 = MFMA32(k0, qf[s], p0); p1 = MFMA32(k1, qf[s], p1);
                asm volatile("" ::: "memory");
            }
            if (64 * j + 63 > q0) {
                const int qa = q0 + ql - 64 * j;
#pragma unroll
                for (int r = 0; r < 16; ++r) { const int kv = crow(r, hi); if (kv > qa) p0[r] = -INFINITY; if (kv + 32 > qa) p1[r] = -INFINITY; }
            }
            float mx = p0[0];
#pragma unroll
            for (int r = 1; r < 16; ++r) mx = fmaxf(mx, p0[r]);
#pragma unroll
            for (int r = 0; r < 16; ++r) mx = fmaxf(mx, p1[r]);
            mx = fmaxf(mx, __shfl_xor(mx, 32));
            const float mnew = fmaxf(mrun, mx), alpha = __builtin_amdgcn_exp2f(mrun - mnew);
            float rs = 0.f;
#pragma unroll
            for (int r = 0; r < 16; ++r) { p0[r] = __builtin_amdgcn_exp2f(p0[r] - mnew); p1[r] = __builtin_amdgcn_exp2f(p1[r] - mnew); rs += p0[r] + p1[r]; }
            lrun = lrun * alpha + rs; mrun = mnew;
#pragma unroll
            for (int d = 0; d < 4; ++d)
#pragma unroll
                for (int r = 0; r < 16; ++r) o[d][r] *= alpha;
            bf16x8 pf[4];
            { u32x4 w;
              w.x = pk2(p0[0], p0[1]); w.y = pk2(p0[2], p0[3]); w.z = pk2(p0[4], p0[5]); w.w = pk2(p0[6], p0[7]); pf[0] = __builtin_bit_cast(bf16x8, w);
              w.x = pk2(p0[8], p0[9]); w.y = pk2(p0[10], p0[11]); w.z = pk2(p0[12], p0[13]); w.w = pk2(p0[14], p0[15]); pf[1] = __builtin_bit_cast(bf16x8, w);
              w.x = pk2(p1[0], p1[1]); w.y = pk2(p1[2], p1[3]); w.z = pk2(p1[4], p1[5]); w.w = pk2(p1[6], p1[7]); pf[2] = __builtin_bit_cast(bf16x8, w);
              w.x = pk2(p1[8], p1[9]); w.y = pk2(p1[10], p1[11]); w.z = pk2(p1[12], p1[13]); w.w = pk2(p1[14], p1[15]); pf[3] = __builtin_bit_cast(bf16x8, w); }
#pragma unroll
            for (int d = 0; d < 4; ++d) {
                const LAS unsigned char* vp = lds + V_OFF + (32 * d + ql) * VROW + 8 * hi;
#pragma unroll
                for (int ks = 0; ks < 4; ++ks) {
                    const u32x2 lo = *(const LAS u32x2*)(vp + 32 * ks), hi2 = *(const LAS u32x2*)(vp + 32 * ks + 16);
                    const u32x4 vv = {lo.x, lo.y, hi2.x, hi2.y};
                    o[d] = MFMA32(__builtin_bit_cast(bf16x8, vv), pf[ks], o[d]);
                }
                asm volatile("" ::: "memory");
            }
        }
    }
#undef ATT_LOAD
    const float ltot = lrun + __shfl_xor(lrun, 32), inv = 1.f / ltot;
    bf16_t* Op = OUTA + ((size_t)b * SEQ + q0 + ql) * 1024 + h * DV;
#pragma unroll
    for (int d = 0; d < 4; ++d)
#pragma unroll
        for (int g = 0; g < 4; ++g) { const int dd = 32 * d + 8 * g + 4 * hi;
            u32x2 w; w.x = pk2(o[d][4 * g] * inv, o[d][4 * g + 1] * inv); w.y = pk2(o[d][4 * g + 2] * inv, o[d][4 * g + 3] * inv);
            *(u32x2*)(Op + dd) = w; }
    __syncthreads();
}
}

namespace ml {
constexpr int QROW = 272, VROW = 136, GROW = 144;
constexpr int Q_OFF = 0, K_OFF = 64 * QROW, KG_OFF = 2 * 64 * QROW, VT_OFF = KG_OFF + 128 * GROW, CT_OFF = VT_OFF + 128 * VROW, G_OFF = CT_OFF + 128 * QROW;
constexpr int GU = 0, GMM = 64, GA_ = 128, GEM = 192, GG = 256, GN = 320, GSS = 448, GSC = 704, G_FLOATS = 712;
constexpr int CWL_OFF = ((G_OFF + G_FLOATS * 4 + 255) / 256) * 256;
static_assert(CWL_OFF + 2 * 5 * 128 * 4 <= RING_BYTES, "mlstm lds");
using att::crow;
#define ML_FENCE() asm volatile("" ::: "memory")
__device__ __forceinline__ void item(int b, int h, const Args& args, LAS unsigned char* lds) {
    unsigned char* ws = args.ws;
    const bf16_t* MLQK = (const bf16_t*)(ws + WS_MLQK); const bf16_t* MLV = (const bf16_t*)(ws + WS_MLV); const bf16_t* SIGO = (const bf16_t*)(ws + WS_SIGO);
    const float* SM = (const float*)(ws + WS_SM); bf16_t* HM = (bf16_t*)(ws + WS_HM);
    const float* conv_w = (const float*)args.in[13]; const float* conv_b = (const float*)args.in[14]; const float* bg = (const float*)args.in[15]; const float* gnorm = (const float*)args.in[16];
    const int tid = fresh_tid(), lane = tid & 63, tl = lane & 31, hi = lane >> 5; const int wid = __builtin_amdgcn_readfirstlane(tid >> 6);
    const int et = wid & 3, tt = wid >> 2;
    LAS float* G = (LAS float*)(lds + G_OFF);
    LAS float* CWL = (LAS float*)(lds + CWL_OFF);
    for (int i = tid; i < 128 * QROW / 4; i += 512) ((LAS unsigned*)(lds + CT_OFF))[i] = 0u;
    if (tid < 128) G[GN + tid] = 0.f;
    for (int i = tid; i < 2 * 5 * 128; i += 512) { const int w2 = i / 640, j = (i % 640) / 128, c = i & 127; const int col = w2 * 1024 + h * 128 + c;
        CWL[i] = (j < 4) ? conv_w[j * 2048 + col] : conv_b[col]; }
    f32x16 cacc[2]; cacc[0] = f32x16{}; cacc[1] = f32x16{};
    float mstate = 0.f;
    const float bi = bg[h], bf_ = bg[8 + h];
    const int which = tid >> 8, tg = (tid >> 4) & 15, cc = tid & 15;
    const int ccol = which * 1024 + h * 128 + 8 * cc;
    const int vhw = tid >> 5, vsp = tid & 31;
    const size_t rowb = (size_t)b * SEQ;
    u32x4 craw[7], vraw[2]; float gi = 0.f, gf = 0.f;
#define ML_LOAD(ck) do { const int t0_ = (ck) * 64; \
        _Pragma("unroll") for (int i = 0; i < 7; ++i) { const int ts = t0_ + 4 * tg - 3 + i; craw[i] = (ts >= 0) ? *(const u32x4*)(MLQK + (rowb + ts) * 2048 + ccol) : (u32x4){0u, 0u, 0u, 0u}; } \
        vraw[0] = *(const u32x4*)(MLV + (rowb + t0_ + 2 * vsp) * 1024 + h * 128 + 8 * vhw); vraw[1] = *(const u32x4*)(MLV + (rowb + t0_ + 2 * vsp + 1) * 1024 + h * 128 + 8 * vhw); \
        if (wid == 0) { gi = SM[(rowb + t0_ + lane) * 256 + 64 + h]; gf = SM[(rowb + t0_ + lane) * 256 + 72 + h]; } } while (0)
    ML_LOAD(0);
    __syncthreads();
    for (int ck = 0; ck < 32; ++ck) {
        const int t0 = ck * 64;
        if (wid == 0) {
            const float fp = gf + bf_, ip = gi + bi;
            const float lf = fminf(fp, 0.f) - __logf(1.f + __expf(-fabsf(fp)));
            float bsum = lf;
#pragma unroll
            for (int o = 1; o < 64; o <<= 1) { const float v = __shfl_up(bsum, o); if (lane >= o) bsum += v; }
            const float u = ip - bsum;
            float M = u;
#pragma unroll
            for (int o = 1; o < 64; o <<= 1) { const float v = __shfl_up(M, o); if (lane >= o) M = fmaxf(M, v); }
            const float mm = fmaxf(M, mstate);
            const float mmL = __shfl(mm, 63), bL = __shfl(bsum, 63);
            G[GU + lane] = u; G[GMM + lane] = mm; G[GA_ + lane] = __expf(mstate - mm); G[GEM + lane] = __expf(-(bsum + mm)); G[GG + lane] = __expf(u - mmL);
            if (lane == 0) G[GSC] = __expf(mstate - mmL);
            mstate = bL + mmL;
        }
        __syncthreads();
        {
            const float ksc = (which == 0) ? 1.f : 0.08838834764831845f;
            float gs[4];
#pragma unroll
            for (int t = 0; t < 4; ++t) gs[t] = G[GG + 4 * tg + t];
            unsigned ow[4][4];
            const LAS float* cwp = CWL + which * 640 + 8 * cc;
#pragma unroll
            for (int w2 = 0; w2 < 4; ++w2) {
                float xa[7], xb[7];
#pragma unroll
                for (int i = 0; i < 7; ++i) { const unsigned wv = (w2 == 0) ? craw[i].x : (w2 == 1) ? craw[i].y : (w2 == 2) ? craw[i].z : craw[i].w; xa[i] = bflo(wv); xb[i] = bfhi(wv); }
                float ya[4], yb[4];
#pragma unroll
                for (int t = 0; t < 4; ++t) { float sa = cwp[4 * 128 + 2 * w2], sb = cwp[4 * 128 + 2 * w2 + 1];
#pragma unroll
                    for (int j = 0; j < 4; ++j) { sa += cwp[j * 128 + 2 * w2] * xa[t + j]; sb += cwp[j * 128 + 2 * w2 + 1] * xb[t + j]; }
                    ya[t] = sa * sigm(sa) * ksc; yb[t] = sb * sigm(sb) * ksc; ow[t][w2] = pk2(ya[t], yb[t]); }
                if (which == 1) {
                    u32x2 wa; wa.x = pk2(ya[0] * gs[0], ya[1] * gs[1]); wa.y = pk2(ya[2] * gs[2], ya[3] * gs[3]);
                    u32x2 wb; wb.x = pk2(yb[0] * gs[0], yb[1] * gs[1]); wb.y = pk2(yb[2] * gs[2], yb[3] * gs[3]);
                    *(LAS u32x2*)(lds + KG_OFF + (8 * cc + 2 * w2) * GROW + 8 * tg) = wa;
                    *(LAS u32x2*)(lds + KG_OFF + (8 * cc + 2 * w2 + 1) * GROW + 8 * tg) = wb;
                }
            }
            const int qk_off = (which == 0) ? Q_OFF : K_OFF;
#pragma unroll
            for (int t = 0; t < 4; ++t) { const u32x4 w = {ow[t][0], ow[t][1], ow[t][2], ow[t][3]}; *(LAS u32x4*)(lds + qk_off + (4 * tg + t) * QROW + 16 * cc) = w; }
            const unsigned a[4] = {vraw[0].x, vraw[0].y, vraw[0].z, vraw[0].w}, c2[4] = {vraw[1].x, vraw[1].y, vraw[1].z, vraw[1].w};
#pragma unroll
            for (int jj = 0; jj < 4; ++jj) {
                const unsigned lo = (a[jj] & 0xffffu) | (c2[jj] << 16), hi2 = (a[jj] >> 16) | (c2[jj] & 0xffff0000u);
                *(LAS unsigned*)(lds + VT_OFF + (8 * vhw + 2 * jj) * VROW + 4 * vsp) = lo;
                *(LAS unsigned*)(lds + VT_OFF + (8 * vhw + 2 * jj + 1) * VROW + 4 * vsp) = hi2;
            }
        }
        if (ck + 1 < 32) ML_LOAD(ck + 1);
        __syncthreads();
        const int t = 32 * tt + tl;
        const float mm_t = G[GMM + t], a_t = G[GA_ + t], em_t = G[GEM + t];
        f32x16 hacc = f32x16{};
        float den = 0.f;
        bf16x8 qf[8];
#pragma unroll
        for (int ks = 0; ks < 8; ++ks) qf[ks] = *(const LAS bf16x8*)(lds + Q_OFF + t * QROW + 32 * ks + 16 * hi);
        ML_FENCE();
#pragma unroll
        for (int st = 0; st < 2; ++st) {
            if (st <= tt) {
                f32x16 p = f32x16{};
#pragma unroll
                for (int ks = 0; ks < 8; ++ks) { const bf16x8 kf = *(const LAS bf16x8*)(lds + K_OFF + (32 * st + tl) * QROW + 32 * ks + 16 * hi); p = MFMA32(kf, qf[ks], p); if ((ks & 3) == 3) ML_FENCE(); }
#pragma unroll
                for (int r = 0; r < 16; ++r) { const int s = 32 * st + crow(r, hi); const float wv = (s <= t) ? __expf(G[GU + s] - mm_t) : 0.f; p[r] *= wv; den += p[r]; }
                bf16x8 pf[2];
                { u32x4 w;
                  w.x = pk2(p[0], p[1]); w.y = pk2(p[2], p[3]); w.z = pk2(p[4], p[5]); w.w = pk2(p[6], p[7]); pf[0] = __builtin_bit_cast(bf16x8, w);
                  w.x = pk2(p[8], p[9]); w.y = pk2(p[10], p[11]); w.z = pk2(p[12], p[13]); w.w = pk2(p[14], p[15]); pf[1] = __builtin_bit_cast(bf16x8, w); }
#pragma unroll
                for (int k2 = 0; k2 < 2; ++k2) {
                    const LAS unsigned char* vp = lds + VT_OFF + (32 * et + tl) * VROW + 32 * (2 * st + k2) + 8 * hi;
                    const u32x2 lo = *(const LAS u32x2*)(vp), hi2 = *(const LAS u32x2*)(vp + 16);
                    const u32x4 vv = {lo.x, lo.y, hi2.x, hi2.y};
                    hacc = MFMA32(__builtin_bit_cast(bf16x8, vv), pf[k2], hacc);
                }
                ML_FENCE();
            }
        }
        den += __shfl_xor(den, 32);
        f32x16 qc = f32x16{};
#pragma unroll
        for (int ks = 0; ks < 8; ++ks) { const bf16x8 cf = *(const LAS bf16x8*)(lds + CT_OFF + (32 * et + tl) * QROW + 32 * ks + 16 * hi); qc = MFMA32(cf, qf[ks], qc); if ((ks & 3) == 3) ML_FENCE(); }
        float dq = 0.f;
#pragma unroll
        for (int i = 0; i < 8; ++i) { const u32x4 qv = *(const LAS u32x4*)(lds + Q_OFF + t * QROW + 128 * hi + 16 * i); const LAS float* np = G + GN + 64 * hi + 8 * i;
            dq += bflo(qv.x) * np[0] + bfhi(qv.x) * np[1] + bflo(qv.y) * np[2] + bfhi(qv.y) * np[3] + bflo(qv.z) * np[4] + bfhi(qv.z) * np[5] + bflo(qv.w) * np[6] + bfhi(qv.w) * np[7];
            if ((i & 1) == 1) ML_FENCE(); }
        dq += __shfl_xor(dq, 32);
        den += a_t * dq;
        const float rden = 1.f / fmaxf(fabsf(den), em_t);
        float ssq = 0.f;
#pragma unroll
        for (int r = 0; r < 16; ++r) { hacc[r] = (hacc[r] + a_t * qc[r]) * rden; ssq += hacc[r] * hacc[r]; }
        ssq += __shfl_xor(ssq, 32);
        if (hi == 0) G[GSS + t * 4 + et] = ssq;
        const size_t orow = (rowb + t0 + t) * 1024 + h * 128 + 32 * et + 4 * hi;
        u32x2 sg[4];
#pragma unroll
        for (int g = 0; g < 4; ++g) sg[g] = *(const u32x2*)(SIGO + orow + 8 * g);
        const float decay = G[GSC];
        __syncthreads();
        {
            const float tot = G[GSS + t * 4] + G[GSS + t * 4 + 1] + G[GSS + t * 4 + 2] + G[GSS + t * 4 + 3];
            const float rstd = 1.f / sqrtf(tot * (1.f / 128.f) + EPS);
#pragma unroll
            for (int g = 0; g < 4; ++g) { const f32x4 gn = *(const f32x4*)(gnorm + h * 128 + 32 * et + 4 * hi + 8 * g); u32x2 w;
                w.x = pk2(hacc[4 * g] * rstd * gn[0] * bflo(sg[g].x), hacc[4 * g + 1] * rstd * gn[1] * bfhi(sg[g].x));
                w.y = pk2(hacc[4 * g + 2] * rstd * gn[2] * bflo(sg[g].y), hacc[4 * g + 3] * rstd * gn[3] * bfhi(sg[g].y));
                *(u32x2*)(HM + orow + 8 * g) = w; }
        }
        ML_FENCE();
#pragma unroll
        for (int i = 0; i < 2; ++i) {
#pragma unroll
            for (int r = 0; r < 16; ++r) cacc[i][r] *= decay;
#pragma unroll
            for (int ks = 0; ks < 4; ++ks) {
                const LAS unsigned char* vp = lds + VT_OFF + (32 * et + tl) * VROW + 32 * ks + 16 * hi;
                const u32x2 lo = *(const LAS u32x2*)(vp), hi2 = *(const LAS u32x2*)(vp + 8);
                const u32x4 vv = {lo.x, lo.y, hi2.x, hi2.y};
                const bf16x8 kg = *(const LAS bf16x8*)(lds + KG_OFF + (32 * (2 * tt + i) + tl) * GROW + 32 * ks + 16 * hi);
                cacc[i] = MFMA32(__builtin_bit_cast(bf16x8, vv), kg, cacc[i]);
            }
#pragma unroll
            for (int r = 0; r < 16; ++r) *(LAS bf16_t*)(lds + CT_OFF + (32 * et + crow(r, hi)) * QROW + 2 * (32 * (2 * tt + i) + tl)) = (bf16_t)f2bf(cacc[i][r]);
            ML_FENCE();
        }
        if (tid < 128) { float s = 0.f;
#pragma unroll
            for (int i = 0; i < 8; ++i) { const u32x4 kv = *(const LAS u32x4*)(lds + KG_OFF + tid * GROW + 16 * i);
                s += bflo(kv.x) + bfhi(kv.x) + bflo(kv.y) + bfhi(kv.y) + bflo(kv.z) + bfhi(kv.z) + bflo(kv.w) + bfhi(kv.w); }
            G[GN + tid] = decay * G[GN + tid] + s; }
    }
#undef ML_LOAD
    __syncthreads();
}
}

__global__ void __launch_bounds__(NWAVES * 64, 2) mk_fwd(Args args) {
    extern __shared__ __attribute__((aligned(16))) unsigned char lds_raw[];
    LAS unsigned char* lds = (LAS unsigned char*)lds_raw;
    volatile LAS unsigned* MISC = (volatile LAS unsigned*)(lds + MISC_OFF);
    const int G = gridDim.x; const int bx = blockIdx.x; const int vcu = (G % 8 == 0) ? (bx % 8) * (G / 8) + bx / 8 : bx;
    unsigned char* ws = args.ws;
    gu32* ctl = (gu32*)(ws + WS_CTL);
    for (int u = threadIdx.x; u < (LDS_BYTES - LDSCTL_OFF) / 4; u += NWAVES * 64) ((LAS unsigned*)(lds + LDSCTL_OFF))[u] = 0u;
    __syncthreads();
    XcdBarrier bar; bar.bar = (unsigned*)(ctl + CW_BAR); bar.x = 0; bar.st = nullptr;
    if (MK_N_LAUNCHES != PER_PHASE) bar = xcd_barrier_post((unsigned*)(ctl + CW_BAR), MISC + 8);
#define GRID_BAR() do { if (MK_N_LAUNCHES != PER_PHASE) xcd_barrier(bar); } while (0)
    const int lo = args.ph_lo, hi = args.ph_hi;
#ifndef PH_MASK
#define PH_MASK 0xfff
#endif
#define IN(k) (((PH_MASK >> (k)) & 1) && lo <= (k) && (k) < hi)
#define BOTH(k) (IN(k) && IN((k) + 1))
#ifndef DUP_MASK
#define DUP_MASK 0
#endif
#define NREP(k) (1 + ((DUP_MASK >> (k)) & 1))
#define LASTREP(k) (rep + 1 == NREP(k))
    const int NGW = G * NWAVES;
#define PHASE_IDS() const int tid = fresh_tid(); const int lane = tid & 63; const int wave = __builtin_amdgcn_readfirstlane(tid >> 6); const int gw = vcu * NWAVES + wave; (void)lane; (void)gw
    float* MOD = (float*)(ws + WS_MOD);

    for (int rep = 0; rep < NREP(0); ++rep) if (IN(0)) {
        PHASE_IDS();
        const float* c_in = (const float*)args.in[1]; const float* w_ada = (const float*)args.in[3]; const float* b_ada = (const float*)args.in[4];
        if (bx < 192) {
            LAS float* scond = (LAS float*)lds; LAS float* part = (LAS float*)(lds + 32768);
            for (int i = tid; i < NB * DM; i += 512) { const float v = c_in[i]; scond[i] = v * sigm(v); }
            __syncthreads();
            const int n0 = 64 * bx, rs = lane >> 4, c4 = lane & 15;
            f32x4 a0 = {0.f, 0.f, 0.f, 0.f}, a1 = a0, a2 = a0, a3 = a0;
#pragma unroll 8
            for (int it = 0; it < 64; ++it) { const int k = 256 * wave + 4 * it + rs; const f32x4 wv = *(const f32x4*)(w_ada + (size_t)k * 12288 + n0 + 4 * c4);
                a0 += wv * scond[k]; a1 += wv * scond[2048 + k]; a2 += wv * scond[4096 + k]; a3 += wv * scond[6144 + k]; }
#pragma unroll
            for (int j = 0; j < 4; ++j) { a0[j] += __shfl_xor(a0[j], 16); a0[j] += __shfl_xor(a0[j], 32); a1[j] += __shfl_xor(a1[j], 16); a1[j] += __shfl_xor(a1[j], 32);
                a2[j] += __shfl_xor(a2[j], 16); a2[j] += __shfl_xor(a2[j], 32); a3[j] += __shfl_xor(a3[j], 16); a3[j] += __shfl_xor(a3[j], 32); }
            if (rs == 0) { *(LAS f32x4*)(part + (wave * 4 + 0) * 64 + 4 * c4) = a0; *(LAS f32x4*)(part + (wave * 4 + 1) * 64 + 4 * c4) = a1;
                *(LAS f32x4*)(part + (wave * 4 + 2) * 64 + 4 * c4) = a2; *(LAS f32x4*)(part + (wave * 4 + 3) * 64 + 4 * c4) = a3; }
            __syncthreads();
            if (tid < 256) { const int b = tid >> 6, col = tid & 63; float s = b_ada[n0 + col];
#pragma unroll
                for (int w = 0; w < 8; ++w) s += part[(w * 4 + b) * 64 + col];
                MOD[b * 12288 + n0 + col] = s; }
            __syncthreads();
        }
        LAS float* scr = (LAS float*)(lds + wave * 16384);
        const float* w_in = (const float*)args.in[6]; const float* w_uq = (const float*)args.in[8]; const float* w_ukv = (const float*)args.in[10];
        const float* w_pa = (const float*)args.in[17]; const float* w_pb = (const float*)args.in[18]; const float* w_out = (const float*)args.in[19];
        const float* w_ge = (const float*)args.in[25]; const float* w_ue = (const float*)args.in[26]; const float* w_de = (const float*)args.in[27];
        const float* qag = (const float*)args.in[7]; const float* kvag = (const float*)args.in[9];
        constexpr int I_IN = 32 * 283, I_UQ = 8 * 48, I_UKV = 4 * 64, I_P = 16 * 64, I_O = 32 * 64, I_G = 32 * 16, I_D = 8 * 64;
        constexpr int NITEMS = I_IN + I_UQ + I_UKV + 2 * I_P + I_O + 32 * (2 * I_G + I_D);
        for (int it = gw; it < NITEMS; it += NGW) {
            int r = it;
            if (r < I_IN) { p0_transpose_item(w_in, DM, INC, (bf16_t*)(ws + WS_WIN), scr, r, lane, nullptr, RmWin{}); continue; } r -= I_IN;
            if (r < I_UQ) { p0_transpose_item(w_uq, QL, 1536, (bf16_t*)(ws + WS_WUQ), scr, r, lane, qag, RmId{}); continue; } r -= I_UQ;
            if (r < I_UKV) { p0_transpose_item(w_ukv, KVL, 2048, (bf16_t*)(ws + WS_WUKV), scr, r, lane, kvag, RmId{}); continue; } r -= I_UKV;
            if (r < I_P) { p0_transpose_item(w_pa, 1024, DM, (bf16_t*)(ws + WS_WPA), scr, r, lane, nullptr, RmId{}); continue; } r -= I_P;
            if (r < I_P) { p0_transpose_item(w_pb, 1024, DM, (bf16_t*)(ws + WS_WPB), scr, r, lane, nullptr, RmId{}); continue; } r -= I_P;
            if (r < I_O) { p0_transpose_item(w_out, DM, DM, (bf16_t*)(ws + WS_WOUT), scr, r, lane, nullptr, RmId{}); continue; } r -= I_O;
            const int e = r / (2 * I_G + I_D); r -= e * (2 * I_G + I_D);
            if (r < I_G) { p0_transpose_item(w_ge + (size_t)e * DM * DFF, DM, DFF, (bf16_t*)(ws + WS_WGU), scr, r, lane, nullptr, RmGate{e * 1024}); continue; } r -= I_G;
            if (r < I_G) { p0_transpose_item(w_ue + (size_t)e * DM * DFF, DM, DFF, (bf16_t*)(ws + WS_WGU), scr, r, lane, nullptr, RmGate{e * 1024 + 128}); continue; } r -= I_G;
            p0_transpose_item(w_de + (size_t)e * DFF * DM, DFF, DM, (bf16_t*)(ws + WS_WD) + (size_t)e * DM * DFF, scr, r, lane, nullptr, RmId{});
        }
        { const float* wgp = (const float*)args.in[21]; const float* wrp = (const float*)args.in[23]; bf16_t* whi = (bf16_t*)(ws + WS_WRT); bf16_t* wlo = whi + 48 * DM;
          for (int i = gw * 64 + lane; i < 48 * 256; i += NGW * 64) { const int o = i >> 8, k0 = (i & 255) * 8; float v[8];
#pragma unroll
              for (int e = 0; e < 8; ++e) v[e] = (o < 32) ? wrp[(size_t)(k0 + e) * 32 + o] : (o < 36) ? wgp[(size_t)(k0 + e) * 4 + (o - 32)] : 0.f;
              unsigned h[8], l[8];
#pragma unroll
              for (int e = 0; e < 8; ++e) { h[e] = f2bf(v[e]); l[e] = f2bf(v[e] - __builtin_bit_cast(float, h[e] << 16)); }
              *(u32x4*)(whi + (size_t)o * DM + k0) = (u32x4){h[0] | (h[1] << 16), h[2] | (h[3] << 16), h[4] | (h[5] << 16), h[6] | (h[7] << 16)};
              *(u32x4*)(wlo + (size_t)o * DM + k0) = (u32x4){l[0] | (l[1] << 16), l[2] | (l[3] << 16), l[4] | (l[5] << 16), l[6] | (l[7] << 16)}; } }
        { u32x4* z = (u32x4*)(ws + WS_WIN + (size_t)848 * DM * 2); const int n16 = 176 * DM * 2 / 16;
          for (int i = gw * 64 + lane; i < n16; i += NGW * 64) z[i] = (u32x4){0u, 0u, 0u, 0u}; }
        if (BOTH(0) || !LASTREP(0)) GRID_BAR();
    }

    for (int rep = 0; rep < NREP(1); ++rep) if (IN(1)) {
        PHASE_IDS();
        const float* x = (const float*)args.in[0]; const float* g = (const float*)args.in[5]; bf16_t* H = (bf16_t*)(ws + WS_H);
        for (int m = gw; m < MTOK; m += NGW) {
            const int b = m >> 11; const f32x4* xr = (const f32x4*)(x + (size_t)m * DM) + lane;
            f32x4 v[8]; float s = 0.f;
#pragma unroll
            for (int j = 0; j < 8; ++j) { v[j] = xr[64 * j]; s += (v[j][0] * v[j][0] + v[j][1] * v[j][1]) + (v[j][2] * v[j][2] + v[j][3] * v[j][3]); }
            const float rstd = 1.f / sqrtf(wave_sum(s) * (1.f / DM) + EPS);
            unsigned long long* o8 = (unsigned long long*)(H + (size_t)m * DM) + lane;
#pragma unroll
            for (int j = 0; j < 8; ++j) { const int k = 4 * (lane + 64 * j); const f32x4 gv = *(const f32x4*)(g + k), sh = *(const f32x4*)(MOD + b * 12288 + k), sc = *(const f32x4*)(MOD + b * 12288 + 2048 + k);
                const f32x4 hv = v[j] * rstd * gv * (sc + 1.f) + sh;
                o8[64 * j] = (unsigned long long)pk2(hv[0], hv[1]) | ((unsigned long long)pk2(hv[2], hv[3]) << 32); }
        }
        { const float* g2 = (const float*)args.in[20]; float* GS2 = (float*)(ws + WS_GS2);
          for (int i = gw * 64 + lane; i < NB * DM; i += NGW * 64) { const int b = i >> 11, k = i & 2047; GS2[i] = g2[k] * (1.f + MOD[b * 12288 + 8192 + k]); }
          if (gw < 144) { const int b = gw / 36, o = gw % 36; const float* wgp = (const float*)args.in[21]; const float* wrp = (const float*)args.in[23];
              float a = 0.f;
              for (int k = lane; k < DM; k += 64) a += MOD[b * 12288 + 6144 + k] * ((o < 32) ? wrp[(size_t)k * 32 + o] : wgp[(size_t)k * 4 + (o - 32)]);
              a = wave_sum(a);
              if (lane == 0) ((float*)(ws + WS_CVEC))[b * 48 + o] = a + ((o < 32) ? ((const float*)args.in[24])[o] : ((const float*)args.in[22])[o - 32]); } }
        if (BOTH(1) || !LASTREP(1)) GRID_BAR();
    }

    for (int rep = 0; rep < NREP(2); ++rep) if (IN(2)) {
        pg8::StaticSched S; S.T.init(MTOK, INCP, G, bx); S.A = (const char*)(ws + WS_H); S.B = (const char*)(ws + WS_WIN); S.K = DM;
        pg8::EpiProj E{ws};
        pg8::gemm_phase<pg8::EpiProj, pg8::StaticSched, false>(lds, DM, S, E);
        if (BOTH(2) || !LASTREP(2)) GRID_BAR();
    }

    for (int rep = 0; rep < NREP(3); ++rep) if (IN(3)) {
        { pg8::StaticSched S; S.T.init(MTOK, 1536, G, bx); S.A = (const char*)(ws + WS_CQ); S.B = (const char*)(ws + WS_WUQ); S.K = QL;
          pg8::EpiBf16 E{(bf16_t*)(ws + WS_QRAW), 1536};
          pg8::gemm_phase<pg8::EpiBf16, pg8::StaticSched, false>(lds, QL, S, E); }
        { pg8::StaticSched S; S.T.init(MTOK, 2048, G, bx); S.A = (const char*)(ws + WS_CKV); S.B = (const char*)(ws + WS_WUKV); S.K = KVL;
          pg8::EpiBf16 E{(bf16_t*)(ws + WS_KVRAW), 2048};
          pg8::gemm_phase<pg8::EpiBf16, pg8::StaticSched, false>(lds, KVL, S, E); }
        if (BOTH(3) || !LASTREP(3)) GRID_BAR();
    }

    for (int rep = 0; rep < NREP(4); ++rep) if (IN(4)) {
        PHASE_IDS();
        const bf16_t* CQ = (const bf16_t*)(ws + WS_CQ); const bf16_t* CKV = (const bf16_t*)(ws + WS_CKV); const float* SM = (const float*)(ws + WS_SM);
        const bf16_t* QRAW = (const bf16_t*)(ws + WS_QRAW); const bf16_t* KVRAW = (const bf16_t*)(ws + WS_KVRAW);
        bf16_t* Qo = (bf16_t*)(ws + WS_Q); bf16_t* Ko = (bf16_t*)(ws + WS_K); bf16_t* Vo = (bf16_t*)(ws + WS_V);
        const int* pos = (const int*)args.in[2]; const float* gq = (const float*)args.in[11]; const float* gk = (const float*)args.in[12];
        const int hh = lane >> 3, jj = lane & 7;
        f32x4 gqv[3][2], gkv[3][2];
#pragma unroll
        for (int c = 0; c < 3; ++c) { gqv[c][0] = *(const f32x4*)(gq + 64 * c + 8 * jj); gqv[c][1] = *(const f32x4*)(gq + 64 * c + 8 * jj + 4);
            gkv[c][0] = *(const f32x4*)(gk + 64 * c + 8 * jj); gkv[c][1] = *(const f32x4*)(gk + 64 * c + 8 * jj + 4); }
        float invf[8];
#pragma unroll
        for (int e = 0; e < 8; ++e) invf[e] = args.inv_freq[8 * (jj & 3) + e];
        for (int tok = gw; tok < MTOK; tok += NGW) {
            const int b = tok >> 11, sq_ = tok & 2047;
            float scq, sckv;
            { const u32x4 w = *(const u32x4*)(CQ + (size_t)tok * QL + 8 * lane); float a = 0.f; a += bflo(w.x) * bflo(w.x) + bfhi(w.x) * bfhi(w.x); a += bflo(w.y) * bflo(w.y) + bfhi(w.y) * bfhi(w.y);
              a += bflo(w.z) * bflo(w.z) + bfhi(w.z) * bfhi(w.z); a += bflo(w.w) * bflo(w.w) + bfhi(w.w) * bfhi(w.w); scq = 1.f / sqrtf(wave_sum(a) * (1.f / QL) + EPS); }
            { const u32x2 w = *(const u32x2*)(CKV + (size_t)tok * KVL + 4 * lane); float a = bflo(w.x) * bflo(w.x) + bfhi(w.x) * bfhi(w.x) + bflo(w.y) * bflo(w.y) + bfhi(w.y) * bfhi(w.y);
              sckv = 1.f / sqrtf(wave_sum(a) * (1.f / KVL) + EPS); }
            const u32x4 q0 = *(const u32x4*)(QRAW + (size_t)tok * 1536 + hh * DQK + 8 * jj), q1 = *(const u32x4*)(QRAW + (size_t)tok * 1536 + hh * DQK + 64 + 8 * jj), q2 = *(const u32x4*)(QRAW + (size_t)tok * 1536 + hh * DQK + 128 + 8 * jj);
            const u32x4 k0 = *(const u32x4*)(KVRAW + (size_t)tok * 2048 + hh * 256 + 8 * jj), k1 = *(const u32x4*)(KVRAW + (size_t)tok * 2048 + hh * 256 + 64 + 8 * jj);
            const u32x4 v0 = *(const u32x4*)(KVRAW + (size_t)tok * 2048 + hh * 256 + 128 + 16 * jj), v1 = *(const u32x4*)(KVRAW + (size_t)tok * 2048 + hh * 256 + 128 + 16 * jj + 8);
            const f32x4 pe0 = *(const f32x4*)(SM + (size_t)tok * 256 + 8 * jj), pe1 = *(const f32x4*)(SM + (size_t)tok * 256 + 8 * jj + 4);
            float cs[8], sn[8];
            { const float fpos = (float)pos[tok];
#pragma unroll
              for (int e = 0; e < 8; ++e) { const float ang = fpos * invf[e]; const float n = rintf(ang * 0.15915494309189535f);
                float r = fmaf(-n, 6.28125f, ang); r = fmaf(-n, C2PI_2, r); r = fmaf(-n, C2PI_3, r);
                const float rev = r * 0.15915494309189535f; cs[e] = __builtin_amdgcn_cosf(rev); sn[e] = __builtin_amdgcn_sinf(rev); } }
            float x[3][8], kk[3][8];
#define UNPK(dst, src_) do { const u32x4 t_ = (src_); dst[0] = bflo(t_.x); dst[1] = bfhi(t_.x); dst[2] = bflo(t_.y); dst[3] = bfhi(t_.y); dst[4] = bflo(t_.z); dst[5] = bfhi(t_.z); dst[6] = bflo(t_.w); dst[7] = bfhi(t_.w); } while (0)
            UNPK(x[0], q0); UNPK(x[1], q1); UNPK(x[2], q2); UNPK(kk[0], k0); UNPK(kk[1], k1);
#pragma unroll
            for (int e = 0; e < 4; ++e) { kk[2][e] = pe0[e]; kk[2][4 + e] = pe1[e]; }
            float sq = 0.f, sk = 0.f, sp = 0.f;
#pragma unroll
            for (int e = 0; e < 8; ++e) { sq += x[0][e] * x[0][e] + x[1][e] * x[1][e] + x[2][e] * x[2][e]; sk += kk[0][e] * kk[0][e] + kk[1][e] * kk[1][e]; sp += kk[2][e] * kk[2][e]; }
            sk = sckv * sckv * sk + sp;
            sq += __shfl_xor(sq, 1); sk += __shfl_xor(sk, 1); sq += __shfl_xor(sq, 2); sk += __shfl_xor(sk, 2); sq += __shfl_xor(sq, 4); sk += __shfl_xor(sk, 4);
            const float rq = scq / sqrtf(scq * scq * sq * (1.f / DQK) + EPS) * QSCALE, rk = 1.f / sqrtf(sk * (1.f / DQK) + EPS);
            const float rkn = rk * sckv;
#pragma unroll
            for (int c = 0; c < 3; ++c)
#pragma unroll
                for (int e = 0; e < 8; ++e) { x[c][e] *= rq * gqv[c][e >> 2][e & 3]; kk[c][e] *= ((c < 2) ? rkn : rk) * gkv[c][e >> 2][e & 3]; }
#pragma unroll
            for (int e = 0; e < 8; ++e) { const float py = __shfl_xor(x[2][e], 4), pz = __shfl_xor(kk[2][e], 4);
                x[2][e] = (jj < 4) ? (x[2][e] * cs[e] - py * sn[e]) : (py * sn[e] + x[2][e] * cs[e]);
                kk[2][e] = (jj < 4) ? (kk[2][e] * cs[e] - pz * sn[e]) : (pz * sn[e] + kk[2][e] * cs[e]); }
            const size_t bhs = ((size_t)(b * NH + hh) * SEQ + sq_);
#pragma unroll
            for (int c = 0; c < 3; ++c) { u32x4 w; w.x = pk2(x[c][0], x[c][1]); w.y = pk2(x[c][2], x[c][3]); w.z = pk2(x[c][4], x[c][5]); w.w = pk2(x[c][6], x[c][7]);
                *(u32x4*)(Qo + bhs * DQK + 64 * c + 8 * jj) = w;
                w.x = pk2(kk[c][0], kk[c][1]); w.y = pk2(kk[c][2], kk[c][3]); w.z = pk2(kk[c][4], kk[c][5]); w.w = pk2(kk[c][6], kk[c][7]);
                *(u32x4*)(Ko + bhs * DQK + 64 * c + 8 * jj) = w; }
            { float vv[8]; u32x4 w; UNPK(vv, v0); w.x = pk2(vv[0] * sckv, vv[1] * sckv); w.y = pk2(vv[2] * sckv, vv[3] * sckv); w.z = pk2(vv[4] * sckv, vv[5] * sckv); w.w = pk2(vv[6] * sckv, vv[7] * sckv);
              *(u32x4*)(Vo + bhs * DV + 16 * jj) = w;
              UNPK(vv, v1); w.x = pk2(vv[0] * sckv, vv[1] * sckv); w.y = pk2(vv[2] * sckv, vv[3] * sckv); w.z = pk2(vv[4] * sckv, vv[5] * sckv); w.w = pk2(vv[6] * sckv, vv[7] * sckv);
              *(u32x4*)(Vo + bhs * DV + 16 * jj + 8) = w; }
#undef UNPK
        }
        if (BOTH(4) || !LASTREP(4)) GRID_BAR();
    }

    for (int rep = 0; rep < NREP(5); ++rep) if (IN(5)) {
        PHASE_IDS();
#ifndef P4_PROBE
#define P4_PROBE 0
#endif
#ifndef NO_ML
        if (bx < 32) {
            if (!(P4_PROBE == 2 && !LASTREP(5)))
            ml::item(bx >> 3, bx & 7, args, lds);
        } else
#endif
#ifndef NO_ATT
        {
            LAS int* qslot = (LAS int*)(lds + MISC_OFF + 64);
            if (!(P4_PROBE == 1 && !LASTREP(5)))
            for (;;) {
                __syncthreads();
                if (tid == 0) *qslot = (int)__hip_atomic_fetch_add(ctl + CW_ATTQ + 64 * rep, 1u, RLX_AGENT);
                __syncthreads();
                const int it = *qslot;
                if (it >= 256) break;
                const int qb = 7 - (it >> 5), bh = it & 31;
                att::unit(bh >> 3, bh & 7, qb, (const bf16_t*)(ws + WS_Q), (const bf16_t*)(ws + WS_K), (const bf16_t*)(ws + WS_V), (bf16_t*)(ws + WS_OUTA), lds);
            }
        }
#else
        {}
#endif
        if (BOTH(5) || !LASTREP(5)) GRID_BAR();
    }

    for (int rep = 0; rep < NREP(6); ++rep) if (IN(6)) {
        pg8::ChainSched S; S.T.init(MTOK, DM, G, bx); S.A0 = (const char*)(ws + WS_OUTA); S.B0 = (const char*)(ws + WS_WPA); S.A1 = (const char*)(ws + WS_HM); S.B1 = (const char*)(ws + WS_WPB); S.K = 1024;
        pg8::EpiMix E{(const bf16_t*)(ws + WS_GA), (const bf16_t*)(ws + WS_GB), (bf16_t*)(ws + WS_MIXED)};
        pg8::gemm_phase<pg8::EpiMix, pg8::ChainSched, false, true>(lds, 1024, S, E);
        if (BOTH(6) || !LASTREP(6)) GRID_BAR();
    }

    for (int rep = 0; rep < NREP(7); ++rep) if (IN(7)) {
        pg8::StaticSched S; S.T.init(MTOK, DM, G, bx); S.A = (const char*)(ws + WS_MIXED); S.B = (const char*)(ws + WS_WOUT); S.K = DM;
        pg8::EpiOut E{(const float*)args.in[0], MOD, args.out};
        pg8::gemm_phase<pg8::EpiOut, pg8::StaticSched, false>(lds, DM, S, E);
        if (BOTH(7) || !LASTREP(7)) GRID_BAR();
    }

    for (int rep = 0; rep < NREP(8); ++rep) if (IN(8)) {
        PHASE_IDS();
        bf16_t* H2 = (bf16_t*)(ws + WS_H); const bool dry = !LASTREP(8); const size_t alt = dry ? (WS_KVRAW + 8 * MiB - WS_TOKINFO) : 0; gu32* ecn = ctl + CW_CNT + (dry ? 64 : 0);
        int* tokinfo = (int*)(ws + WS_TOKINFO + alt); int* tokof = (int*)(ws + WS_TOKOF + alt); float* combof = (float*)(ws + WS_COMBOF + alt);
        const float* GS2 = (const float*)(ws + WS_GS2); const float* CVEC = (const float*)(ws + WS_CVEC);
        const bf16_t* whi = (const bf16_t*)(ws + WS_WRT); const bf16_t* wlo = whi + 48 * DM;
        LAS float* red = (LAS float*)lds; LAS float* ssqp = (LAS float*)(lds + 24576); LAS float* rsl = (LAS float*)(lds + 25088);
        const int r = lane & 15, kq = lane >> 4;
        for (int rt = bx; rt < MTOK / 16; rt += G) {
            const int row0 = rt * 16, b = row0 >> 11;
            const float* xrow = args.out + (size_t)(row0 + r) * DM + 256 * wave + 8 * kq;
            const float* gsr = GS2 + b * DM + 256 * wave + 8 * kq;
            float v[8][8]; float ssq = 0.f;
            f32x4 acc[3] = {(f32x4){0.f, 0.f, 0.f, 0.f}, (f32x4){0.f, 0.f, 0.f, 0.f}, (f32x4){0.f, 0.f, 0.f, 0.f}};
#pragma unroll
            for (int ks = 0; ks < 8; ++ks) {
                const f32x4 x0 = *(const f32x4*)(xrow + 32 * ks), x1 = *(const f32x4*)(xrow + 32 * ks + 4), g0 = *(const f32x4*)(gsr + 32 * ks), g1 = *(const f32x4*)(gsr + 32 * ks + 4);
                unsigned hw[8], lw[8];
#pragma unroll
                for (int e = 0; e < 8; ++e) { const float xv = (e < 4) ? x0[e & 3] : x1[e & 3]; const float gv = (e < 4) ? g0[e & 3] : g1[e & 3];
                    ssq += xv * xv; const float t = xv * gv; v[ks][e] = t; hw[e] = f2bf(t); lw[e] = f2bf(t - __builtin_bit_cast(float, hw[e] << 16)); }
                const u32x4 ah = {hw[0] | (hw[1] << 16), hw[2] | (hw[3] << 16), hw[4] | (hw[5] << 16), hw[6] | (hw[7] << 16)};
                const u32x4 al = {lw[0] | (lw[1] << 16), lw[2] | (lw[3] << 16), lw[4] | (lw[5] << 16), lw[6] | (lw[7] << 16)};
                const bf16x8 ahi = __builtin_bit_cast(bf16x8, ah), alo = __builtin_bit_cast(bf16x8, al);
#pragma unroll
                for (int nt = 0; nt < 3; ++nt) { const size_t wo = (size_t)(16 * nt + r) * DM + 256 * wave + 32 * ks + 8 * kq;
                    const bf16x8 bh = *(const bf16x8*)(whi + wo), bl = *(const bf16x8*)(wlo + wo);
                    acc[nt] = __builtin_amdgcn_mfma_f32_16x16x32_bf16(ahi, bh, acc[nt], 0, 0, 0);
                    acc[nt] = __builtin_amdgcn_mfma_f32_16x16x32_bf16(alo, bh, acc[nt], 0, 0, 0);
                    acc[nt] = __builtin_amdgcn_mfma_f32_16x16x32_bf16(ahi, bl, acc[nt], 0, 0, 0); }
            }
            ssq += __shfl_xor(ssq, 16); ssq += __shfl_xor(ssq, 32);
            if (kq == 0) ssqp[wave * 16 + r] = ssq;
#pragma unroll
            for (int nt = 0; nt < 3; ++nt)
#pragma unroll
                for (int i = 0; i < 4; ++i) red[(wave * 16 + 4 * kq + i) * 48 + 16 * nt + r] = acc[nt][i];
            __syncthreads();
            LAS float* lgl = (LAS float*)(lds + 25600);
            for (int i = tid; i < 16 * 36; i += 512) { const int tk = i / 36, o = i - tk * 36; float sq = 0.f, a = 0.f;
#pragma unroll
                for (int w = 0; w < 8; ++w) { sq += ssqp[w * 16 + tk]; a += red[(w * 16 + tk) * 48 + o]; }
                const float rstd = 1.f / sqrtf(sq * (1.f / DM) + EPS);
                if (o == 0) rsl[tk] = rstd;
                lgl[tk * 48 + o] = a * rstd + CVEC[b * 48 + o]; }
            __syncthreads();
            if (tid < 16) {
                const int m = row0 + tid;
                const LAS float* lg = lgl + tid * 48;
                int gs = 0; float gmx = lg[32];
#pragma unroll
                for (int i = 1; i < 4; ++i) if (lg[32 + i] > gmx) { gmx = lg[32 + i]; gs = i; }
                float gsum = 0.f;
#pragma unroll
                for (int i = 0; i < 4; ++i) gsum += __expf(lg[32 + i] - gmx);
                const float gwt = 1.f / gsum;
                float el[8];
#pragma unroll
                for (int i = 0; i < 8; ++i) { float a = lg[i]; a = (gs == 1) ? lg[8 + i] : a; a = (gs == 2) ? lg[16 + i] : a; a = (gs == 3) ? lg[24 + i] : a; el[i] = a; }
                int i0 = 0; float m0 = el[0];
#pragma unroll
                for (int i = 1; i < 8; ++i) if (el[i] > m0) { m0 = el[i]; i0 = i; }
                int i1 = -1; float m1 = -INFINITY;
#pragma unroll
                for (int i = 0; i < 8; ++i) if (i != i0 && el[i] > m1) { m1 = el[i]; i1 = i; }
                const float p1 = __expf(m1 - m0), w0 = gwt / (1.f + p1), w1 = gwt * p1 / (1.f + p1);
                const int e0 = gs * 8 + i0, e1 = gs * 8 + i1;
                const int pos0 = (int)__hip_atomic_fetch_add(ecn + e0, 1u, RLX_AGENT), pos1 = (int)__hip_atomic_fetch_add(ecn + e1, 1u, RLX_AGENT);
                tokof[e0 * 8192 + pos0] = m; combof[e0 * 8192 + pos0] = w0; tokof[e1 * 8192 + pos1] = m; combof[e1 * 8192 + pos1] = w1;
                tokinfo[m * 4 + 0] = e0; tokinfo[m * 4 + 1] = pos0; tokinfo[m * 4 + 2] = e1; tokinfo[m * 4 + 3] = pos1;
            }
            __syncthreads();
            {
                const float rstd = rsl[r];
                const float* shr = MOD + b * 12288 + 6144 + 256 * wave + 8 * kq;
                bf16_t* orow = H2 + (size_t)(row0 + r) * DM + 256 * wave + 8 * kq;
#pragma unroll
                for (int ks = 0; ks < 8; ++ks) { const f32x4 s0 = *(const f32x4*)(shr + 32 * ks), s1 = *(const f32x4*)(shr + 32 * ks + 4);
                    u32x4 w; w.x = pk2(v[ks][0] * rstd + s0[0], v[ks][1] * rstd + s0[1]); w.y = pk2(v[ks][2] * rstd + s0[2], v[ks][3] * rstd + s0[3]);
                    w.z = pk2(v[ks][4] * rstd + s1[0], v[ks][5] * rstd + s1[1]); w.w = pk2(v[ks][6] * rstd + s1[2], v[ks][7] * rstd + s1[3]);
                    *(u32x4*)(orow + 32 * ks) = w; }
            }
            __syncthreads();
        }
        if (BOTH(8) || !LASTREP(8)) GRID_BAR();
    }

    LAS int* tstart = (LAS int*)(lds + MISC_OFF + 128); LAS int* ecnt = (LAS int*)(lds + MISC_OFF + 128 + 33 * 4 + 12);
    if (IN(9) || IN(10) || IN(11)) {
        __syncthreads();
        if (threadIdx.x == 0) { int acc = 0; for (int e = 0; e < 32; ++e) { const int c = (int)__hip_atomic_load(ctl + CW_CNT + e, RLX_AGENT); ecnt[e] = c; tstart[e] = acc; acc += (c + 255) >> 8; } tstart[32] = acc; }
        __syncthreads();
    }

    for (int rep = 0; rep < NREP(9); ++rep) if (IN(9)) {
        pg8::MoeUpSched S{tstart, ecnt, (const int*)(ws + WS_TOKOF), (const char*)(ws + WS_H), (const char*)(ws + WS_WGU), G, bx};
        pg8::EpiMoeUp E{(const float*)(ws + WS_COMBOF), (bf16_t*)(ws + WS_ACT)};
        pg8::gemm_phase<pg8::EpiMoeUp, pg8::MoeUpSched, true>(lds, DM, S, E);
        if (BOTH(9) || !LASTREP(9)) GRID_BAR();
    }

    for (int rep = 0; rep < NREP(10); ++rep) if (IN(10)) {
        pg8::MoeDownSched S{tstart, (const char*)(ws + WS_ACT), (const char*)(ws + WS_WD), G, bx};
        pg8::EpiBf16 E{(bf16_t*)(ws + WS_Y), DM};
        pg8::gemm_phase<pg8::EpiBf16, pg8::MoeDownSched, false>(lds, DFF, S, E);
        if (BOTH(10) || !LASTREP(10)) GRID_BAR();
    }

    for (int rep = 0; rep < NREP(11); ++rep) if (IN(11)) {
        PHASE_IDS();
        const bf16_t* Y = (const bf16_t*)(ws + WS_Y); const int* tokinfo = (const int*)(ws + WS_TOKINFO);
        for (int m = gw; m < MTOK; m += NGW) {
            const int b = m >> 11;
            const int e0 = tokinfo[m * 4], p0 = tokinfo[m * 4 + 1], e1 = tokinfo[m * 4 + 2], p1 = tokinfo[m * 4 + 3];
            const size_t s0 = (size_t)tstart[e0] * 256 + p0, s1 = (size_t)tstart[e1] * 256 + p1;
            const f32x4* xr = (const f32x4*)(args.out + (size_t)m * DM) + lane;
            f32x4* ow = (LASTREP(11) ? (f32x4*)(args.out + (size_t)m * DM) : (f32x4*)(ws + WS_MIXED + (size_t)m * DM * 4)) + lane;
            const u32x2* y0 = (const u32x2*)(Y + s0 * DM) + lane; const u32x2* y1 = (const u32x2*)(Y + s1 * DM) + lane;
#pragma unroll
            for (int j = 0; j < 8; ++j) { const int k = 4 * (lane + 64 * j); const f32x4 gt = *(const f32x4*)(MOD + b * 12288 + 10240 + k);
                const u32x2 a = y0[64 * j], c = y1[64 * j]; const f32x4 xv = xr[64 * j];
                const f32x4 mo = {bflo(a.x) + bflo(c.x), bfhi(a.x) + bfhi(c.x), bflo(a.y) + bflo(c.y), bfhi(a.y) + bfhi(c.y)};
                ow[64 * j] = xv + gt * mo; }
        }
        if (!LASTREP(11)) GRID_BAR();
    }
#undef IN
#undef BOTH
#undef GRID_BAR
}

extern "C" void kernel_launch(void* const* d_in, const int* in_sizes, int n_in, void* d_out, int out_size, void* d_ws, size_t ws_size, hipStream_t stream) {
    static int grid = 0;
    if (grid == 0) {
        if (n_in != 28 || in_sizes[0] != MTOK * DM || out_size != MTOK * DM || ws_size < WS_END) {
            fprintf(stderr, "kernel_launch: unexpected shapes (n_in %d in0 %d out %d ws %zu need %zu)\n", n_in, n_in > 0 ? in_sizes[0] : -1, out_size, ws_size, (size_t)WS_END); grid = -1; return; }
        int dev = 0, cus = 0, per_cu = 0;
        if (hipGetDevice(&dev) != hipSuccess || hipDeviceGetAttribute(&cus, hipDeviceAttributeMultiprocessorCount, dev) != hipSuccess) { grid = -1; return; }
        if (hipFuncSetAttribute((const void*)mk_fwd, hipFuncAttributeMaxDynamicSharedMemorySize, LDS_BYTES) != hipSuccess) { fprintf(stderr, "kernel_launch: hipFuncSetAttribute failed\n"); grid = -1; return; }
        if (hipOccupancyMaxActiveBlocksPerMultiprocessor(&per_cu, (const void*)mk_fwd, NWAVES * 64, LDS_BYTES) != hipSuccess || per_cu < 1)
            fprintf(stderr, "kernel_launch: occupancy query reports %d blocks per CU\n", per_cu);
        (void)hipGetLastError();
        grid = cus;
    }
    if (grid < 0) return;
    (void)hipMemsetAsync((char*)d_ws + WS_CTL, 0, CTL_ZERO_BYTES, stream);
    Args a{};
    for (int i = 0; i < 28; ++i) a.in[i] = d_in[i];
    a.out = (float*)d_out; a.ws = (unsigned char*)d_ws;
    for (int i = 0; i < 32; ++i) a.inv_freq[i] = (float)pow(10000.0, -(double)(2 * i) / 64.0);
#if MK_N_LAUNCHES == 1
    a.ph_lo = 0; a.ph_hi = PER_PHASE; a.li = 0;
    hipLaunchKernelGGL(mk_fwd, dim3(grid), dim3(NWAVES * 64), LDS_BYTES, stream, a);
#else
    for (int li = 0; li < PER_PHASE; ++li) { a.ph_lo = li; a.ph_hi = li + 1; a.li = li;
        hipLaunchKernelGGL(mk_fwd, dim3(grid), dim3(NWAVES * 64), LDS_BYTES, stream, a); }
#endif
}
```

```cpp
#include <hip/hip_runtime.h>
#include <hip/hip_bf16.h>
#include <cstdio>
#include <cstdint>
#include <cmath>

#ifndef MK_N_LAUNCHES
#define MK_N_LAUNCHES 1
#endif

#define LAS __attribute__((address_space(3)))
#define GAS __attribute__((address_space(1)))
typedef unsigned short bf16_t;
typedef short bf16x8 __attribute__((ext_vector_type(8)));
typedef short s16x4 __attribute__((ext_vector_type(4)));
typedef float f32x4 __attribute__((ext_vector_type(4)));
typedef float f32x2 __attribute__((ext_vector_type(2)));
typedef float f32x16 __attribute__((ext_vector_type(16)));
typedef unsigned u32x4 __attribute__((ext_vector_type(4)));
typedef unsigned u32x2 __attribute__((ext_vector_type(2)));
typedef __bf16 bf16x2_t __attribute__((ext_vector_type(2)));
typedef GAS unsigned gu32;

constexpr int DM = 2048, NB = 4, SEQ = 2048, MTOK = NB * SEQ;
constexpr int NH = 8, DQK = 192, DNOPE = 128, DROPE = 64, DV = 128;
constexpr int QL = 512, KVL = 256;
constexpr int INC = 9040, INCP = 9216;
constexpr int NE = 32, DFF = 512;
constexpr float EPS = 1e-6f;
constexpr int SLOT_CAP = 24576;
constexpr float QSCALE = 0.07216878364870322f * 1.4426950408889634f;
constexpr float C2PI_2 = 0.0019353071693331003f, C2PI_3 = 1.0253131677018246e-11f;

constexpr size_t MiB = 1u << 20;
constexpr size_t WS_CTL = 0, CTL_ZERO_BYTES = 1 * MiB;
constexpr size_t WS_MOD = 1 * MiB;
constexpr size_t WS_CVEC = WS_MOD + 200 * 1024;
constexpr size_t WS_GS2 = WS_MOD + 208 * 1024;
constexpr size_t WS_WRT = WS_MOD + 256 * 1024;
constexpr size_t WS_WUQ = 2 * MiB;
constexpr size_t WS_WUKV = 4 * MiB;
constexpr size_t WS_TOKINFO = 5 * MiB;
constexpr size_t WS_TOKOF = 6 * MiB;
constexpr size_t WS_COMBOF = 7 * MiB;
constexpr size_t WS_WIN = 8 * MiB;
constexpr size_t WS_WPA = 44 * MiB, WS_WPB = 48 * MiB, WS_WOUT = 52 * MiB;
constexpr size_t WS_WGU = 60 * MiB;
constexpr size_t WS_WD = 188 * MiB;
constexpr size_t WS_H = 252 * MiB;
constexpr size_t WS_CQ = 284 * MiB, WS_CKV = 292 * MiB, WS_SM = 296 * MiB;
constexpr size_t WS_MLQK = 304 * MiB, WS_MLV = 336 * MiB, WS_SIGO = 352 * MiB, WS_GA = 368 * MiB, WS_GB = 400 * MiB;
constexpr size_t WS_Y = 304 * MiB;
constexpr size_t WS_ACT = 400 * MiB;
constexpr size_t WS_QRAW = 432 * MiB, WS_KVRAW = 456 * MiB;
constexpr size_t WS_MIXED = 432 * MiB;
constexpr size_t WS_Q = 488 * MiB, WS_K = 512 * MiB, WS_V = 536 * MiB;
constexpr size_t WS_OUTA = 552 * MiB, WS_HM = 568 * MiB;
constexpr size_t WS_MQK = 584 * MiB;
constexpr size_t WS_END = 616 * MiB;

constexpr int CW_TMO = 0;
constexpr int CW_CNT = 1024;
constexpr int CW_ATTQ = 2048;
constexpr int CW_BGQ = 3072;
constexpr int CW_P0Q = 3136;
constexpr int CW_FGDONE = 3200;
constexpr int CW_BAR = 4096;

constexpr int LDS_BYTES = 163840;
constexpr int RING_BYTES = LDS_BYTES - 2048;
constexpr int LDSCTL_OFF = RING_BYTES, MISC_OFF = LDSCTL_OFF + 320;
constexpr int NWAVES = 8;

#define RLX_AGENT __ATOMIC_RELAXED, __HIP_MEMORY_SCOPE_AGENT
#define LDS_WAIT() asm volatile("s_waitcnt lgkmcnt(0)" ::: "memory")
#define VM_WAIT() asm volatile("s_waitcnt vmcnt(0)" ::: "memory")

__device__ __forceinline__ unsigned f2bf(float f) { unsigned u = __builtin_bit_cast(unsigned, f); return (u + 0x7fffu + ((u >> 16) & 1u)) >> 16; }
__device__ __forceinline__ unsigned pk2(float lo, float hi) { f32x2 v = {lo, hi}; bf16x2_t b = __builtin_convertvector(v, bf16x2_t); return __builtin_bit_cast(unsigned, b); }
__device__ __forceinline__ float bflo(unsigned w) { return __builtin_bit_cast(float, w << 16); }
__device__ __forceinline__ float bfhi(unsigned w) { return __builtin_bit_cast(float, w & 0xffff0000u); }
__device__ __forceinline__ float bf1(bf16_t h) { return __builtin_bit_cast(float, (unsigned)h << 16); }
__device__ __forceinline__ float sigm(float x) { return __builtin_amdgcn_rcpf(1.f + __expf(-x)); }
__device__ __forceinline__ int fresh_tid() { int t = threadIdx.x; asm volatile("" : "+v"(t)); return t; }
__device__ __forceinline__ float wave_sum(float v) {
#pragma unroll
    for (int o = 1; o < 64; o <<= 1) v += __shfl_xor(v, o);
    return v;
}

namespace pg8 {
constexpr int BM = 256, BK = 64, HALF = 128, HTB = HALF * BK * 2, STAGE_BYTES = 8 * HTB, NXCD = 8, WGM = 8;
__host__ __device__ __forceinline__ int lds_byte(int r, int c) { const int st = (r >> 4) * 2 + (c >> 5), rr = r & 15, cc = c & 31, ob = rr * 64 + cc * 2; return st * 1024 + (ob ^ (((ob >> 9) & 1) << 5)); }
__host__ __device__ __forceinline__ void stage_rc(int b, int& R, int& C) { const int st = b / 1024, sb = b % 1024, swz = sb ^ (((sb >> 9) & 1) << 5); R = (st >> 1) * 16 + swz / 64; C = (st & 1) * 32 + (swz % 64) / 2; }
__host__ __device__ __forceinline__ int perm32(int rho) { const int n = rho >> 4, i = rho & 15; return 8 * (i >> 2) + 4 * n + (i & 3); }

struct Unit { const char* A; const char* B; const char* A2; const char* B2; int pm, pn, e, r0, cnt; };

struct TileOrder {
    int nM, nN, nwg, G, c;
    __device__ __forceinline__ void init(int M, int N, int G_, int c_) { nM = M / BM; nN = N / BM; nwg = nM * nN; G = G_; c = c_; }
    __device__ __forceinline__ bool tile(int i, int& pm, int& pn) const {
        const long L = (long)i * G + c; if (L >= nwg) return false;
        int wgid = (int)L; { const int q = nwg / NXCD, r = nwg % NXCD, xcd = wgid % NXCD, off = wgid / NXCD; wgid = (xcd < r ? xcd * (q + 1) : r * (q + 1) + (xcd - r) * q) + off; }
        const int nig = WGM * nN, gid = wgid / nig, fm = gid * WGM, gsz = (nM - fm) < WGM ? (nM - fm) : WGM;
        pm = fm + ((wgid % nig) % gsz); pn = (wgid % nig) / gsz; return true;
    }
};
struct StaticSched {
    TileOrder T; const char* A; const char* B; int K;
    __device__ __forceinline__ bool next(int i, Unit& u) const { int pm, pn; if (!T.tile(i, pm, pn)) return false; u.pm = pm; u.pn = pn; u.e = 0; u.r0 = 0; u.cnt = 0;
        u.A = A + (size_t)pm * BM * K * 2; u.B = B + (size_t)pn * BM * K * 2; u.A2 = u.A; u.B2 = u.B; return true; }
    __device__ __forceinline__ int tok(const Unit&, int r) const { return r; }
};
struct ChainSched {
    TileOrder T; const char* A0; const char* B0; const char* A1; const char* B1; int K;
    __device__ __forceinline__ bool next(int i, Unit& u) const { int pm, pn; if (!T.tile(i, pm, pn)) return false; u.pm = pm; u.pn = pn; u.e = 0; u.r0 = 0; u.cnt = 0;
        u.A = A0 + (size_t)pm * BM * K * 2; u.B = B0 + (size_t)pn * BM * K * 2; u.A2 = A1 + (size_t)pm * BM * K * 2; u.B2 = B1 + (size_t)pn * BM * K * 2; return true; }
    __device__ __forceinline__ int tok(const Unit&, int r) const { return r; }
};
struct MoeUpSched {
    const LAS int* tstart; const LAS int* cnt; const int* tokof; const char* A; const char* B; int G, c;
    __device__ __forceinline__ bool next(int i, Unit& u) const {
        const int L = i * G + c, ntot = tstart[32] * 4; if (L >= ntot) return false;
        const int T = L >> 2; int e = 0;
        for (int j = 1; j < 32; ++j) e = (T >= tstart[j]) ? j : e;
        e = __builtin_amdgcn_readfirstlane(e);
        const int mt = T - tstart[e];
        u.pm = T; u.pn = L & 3; u.e = e; u.r0 = mt * 256; u.cnt = cnt[e];
        u.A = A; u.B = B + ((size_t)e * 1024 + (size_t)u.pn * 256) * 2048 * 2; u.A2 = u.A; u.B2 = u.B; return true; }
    __device__ __forceinline__ int tok(const Unit& u, int r) const { const int rr = u.r0 + r; return tokof[u.e * 8192 + (rr < u.cnt ? rr : u.r0)]; }
};
struct MoeDownSched {
    const LAS int* tstart; const char* A; const char* B; int G, c;
    __device__ __forceinline__ bool next(int i, Unit& u) const {
        const int L = i * G + c, ntot = tstart[32] * 8; if (L >= ntot) return false;
        const int T = L >> 3; int e = 0;
        for (int j = 1; j < 32; ++j) e = (T >= tstart[j]) ? j : e;
        e = __builtin_amdgcn_readfirstlane(e);
        u.pm = T; u.pn = L & 7; u.e = e; u.r0 = 0; u.cnt = 0;
        u.A = A + (size_t)T * 256 * 512 * 2; u.B = B + ((size_t)e * 2048 + (size_t)u.pn * 256) * 512 * 2; u.A2 = u.A; u.B2 = u.B; return true; }
    __device__ __forceinline__ int tok(const Unit&, int r) const { return r; }
};

template <class Epi, class Sched, bool GATHER, bool CHAIN = false>
__device__ __forceinline__ void gemm_phase(LAS unsigned char* lds, const int K, const Sched& S, const Epi& E) {
    const int tid = fresh_tid(), wid = __builtin_amdgcn_readfirstlane(tid >> 6), lane = tid & 63, wr = wid >> 2, wc = wid & 3, fr = lane & 15, fq = lane >> 4;
    const int nt = K / BK;
    int sR[2], sC[2]; unsigned voffB[2];
#pragma unroll
    for (int i = 0; i < 2; ++i) { int R, C; stage_rc(tid * 16 + i * 8192, R, C); sR[i] = R; sC[i] = C; const int Rb = Epi::PERM ? ((R & ~31) + perm32(R & 31)) : R; voffB[i] = (unsigned)(Rb * K + C) * 2u; }
    const size_t kstep = (size_t)(BK * 2);
    const size_t hstep = (size_t)HALF * K * 2;
    const unsigned ldsw = (unsigned)wid * 1024u;
    const int aoff = lds_byte(wr * 64 + fr, fq * 8), boff = lds_byte(wc * 32 + fr, fq * 8);
#define PG8_SA(b, h) (((b) * 2 + (h)) * HTB)
#define PG8_SB(b, h) ((4 + (b) * 2 + (h)) * HTB)
#define PG8_STAGE(bufoff, gbase, voff) do { _Pragma("unroll") for (int _i = 0; _i < 2; ++_i) \
        __builtin_amdgcn_global_load_lds((const unsigned*)((const char*)(gbase) + (voff)[_i]), (LAS unsigned*)(lds + (bufoff) + ldsw + _i * 8192), 16, 0, 0); } while (0)
#define PG8_LDA(dst, b, h) do { _Pragma("unroll") for (int m = 0; m < 4; ++m) _Pragma("unroll") for (int k = 0; k < 2; ++k) dst[m][k] = *(const LAS bf16x8*)(lds + PG8_SA(b, h) + aoff + m * 2048 + k * 1024); } while (0)
#define PG8_LDB(dst, b, h) do { _Pragma("unroll") for (int n = 0; n < 2; ++n) _Pragma("unroll") for (int k = 0; k < 2; ++k) dst[n][k] = *(const LAS bf16x8*)(lds + PG8_SB(b, h) + boff + n * 2048 + k * 1024); } while (0)
#define PG8_MMA(ai, bj, At, Bt) do { __builtin_amdgcn_s_setprio(1); _Pragma("unroll") for (int m = 0; m < 4; ++m) _Pragma("unroll") for (int n = 0; n < 2; ++n) _Pragma("unroll") for (int k = 0; k < 2; ++k) \
        acc[ai][bj][m][n] = __builtin_amdgcn_mfma_f32_16x16x32_bf16(Bt[n][k], At[m][k], acc[ai][bj][m][n], 0, 0, 0); __builtin_amdgcn_s_setprio(0); } while (0)
#define PG8_WAIT_V(n) asm volatile("s_waitcnt vmcnt(" #n ")" ::: "memory")
#define PG8_WAIT_L(n) asm volatile("s_waitcnt lgkmcnt(" #n ")" ::: "memory")
#define PG8_BAR __builtin_amdgcn_s_barrier()
#define PG8_SCHED __builtin_amdgcn_sched_barrier(0)
#define PG8_OFFS(dst, unit) do { _Pragma("unroll") for (int _h = 0; _h < 2; ++_h) _Pragma("unroll") for (int _i = 0; _i < 2; ++_i) { \
        const int _row = GATHER ? S.tok(unit, _h * HALF + sR[_i]) : (_h * HALF + sR[_i]); dst[_h][_i] = (unsigned)(_row * K + sC[_i]) * 2u; } } while (0)
#define PG8_KLOOP(cA_, cB_, nA_, nB_, useN_) do { \
        for (int t = 0; t < nt; t += 2) { \
            const bool last = (t == nt - 2); \
            const char* a1 = (cA_) + (size_t)(t + 1) * kstep; \
            const char* a2 = last ? (nA_) : (cA_) + (size_t)(t + 2) * kstep; const char* b2 = last ? (nB_) : (cB_) + (size_t)(t + 2) * kstep; \
            const char* a3 = a2 + kstep; const char* b3 = b2 + kstep; \
            unsigned o2[2][2]; \
_Pragma("unroll") \
            for (int h = 0; h < 2; ++h) \
_Pragma("unroll") \
                for (int i = 0; i < 2; ++i) o2[h][i] = (GATHER && last && (useN_)) ? voN[h][i] : voA[h][i]; \
            PG8_LDB(B0, 0, 0); PG8_LDB(B1, 0, 1); PG8_SCHED; PG8_LDA(At, 0, 0); PG8_STAGE(PG8_SA(1, 1), a1, voA[1]); \
            PG8_WAIT_V(8); PG8_WAIT_L(0); PG8_BAR; PG8_MMA(0, 0, At, B0); PG8_MMA(0, 1, At, B1); PG8_BAR; PG8_SCHED; \
            PG8_LDA(At, 0, 1); PG8_STAGE(PG8_SB(0, 0), b2, voffB); PG8_STAGE(PG8_SB(0, 1), b2 + hstep, voffB); PG8_STAGE(PG8_SA(0, 0), a2, o2[0]); \
            PG8_WAIT_V(8); PG8_WAIT_L(0); PG8_BAR; PG8_MMA(1, 0, At, B0); PG8_MMA(1, 1, At, B1); PG8_BAR; PG8_SCHED; \
            PG8_LDB(B0, 1, 0); PG8_LDB(B1, 1, 1); PG8_SCHED; PG8_LDA(At, 1, 0); PG8_STAGE(PG8_SA(0, 1), a2, o2[1]); \
            PG8_WAIT_V(8); PG8_WAIT_L(0); PG8_BAR; PG8_MMA(0, 0, At, B0); PG8_MMA(0, 1, At, B1); PG8_BAR; PG8_SCHED; \
            PG8_LDA(At, 1, 1); PG8_STAGE(PG8_SB(1, 0), b3, voffB); PG8_STAGE(PG8_SB(1, 1), b3 + hstep, voffB); PG8_STAGE(PG8_SA(1, 0), a3, o2[0]); \
            PG8_WAIT_V(8); PG8_WAIT_L(0); PG8_BAR; PG8_MMA(1, 0, At, B0); PG8_MMA(1, 1, At, B1); PG8_BAR; PG8_SCHED; \
        } \
    } while (0)
    Unit cur, nxt; int ui = 0;
    if (!S.next(0, cur)) return;
    f32x4 acc[2][2][4][2];
#pragma unroll
    for (int a = 0; a < 2; ++a)
#pragma unroll
        for (int b = 0; b < 2; ++b)
#pragma unroll
            for (int m = 0; m < 4; ++m)
#pragma unroll
                for (int n = 0; n < 2; ++n) acc[a][b][m][n] = (f32x4){0.f, 0.f, 0.f, 0.f};
    bf16x8 At[4][2], B0[2][2], B1[2][2];
    unsigned voA[2][2], voN[2][2];
    PG8_OFFS(voA, cur);
    const char* cA = cur.A; const char* cB = cur.B;
    PG8_STAGE(PG8_SB(0, 0), cB, voffB); PG8_STAGE(PG8_SB(0, 1), cB + hstep, voffB); PG8_STAGE(PG8_SA(0, 0), cA, voA[0]); PG8_STAGE(PG8_SA(0, 1), cA, voA[1]);
    if (wr == 1) PG8_BAR;
    PG8_WAIT_V(2); PG8_BAR;
    PG8_STAGE(PG8_SB(1, 0), cB + kstep, voffB); PG8_STAGE(PG8_SA(1, 0), cA + kstep, voA[0]); PG8_STAGE(PG8_SB(1, 1), cB + hstep + kstep, voffB);
    PG8_WAIT_V(6); PG8_BAR;
    for (;;) {
        const bool has_next = S.next(ui + 1, nxt);
        const char* nA = has_next ? nxt.A : cA; const char* nB = has_next ? nxt.B : cB;
        if (GATHER) { if (has_next) { PG8_OFFS(voN, nxt); } else {
#pragma unroll
            for (int h = 0; h < 2; ++h)
#pragma unroll
                for (int i = 0; i < 2; ++i) voN[h][i] = voA[h][i]; } }
        if constexpr (CHAIN) { PG8_KLOOP(cA, cB, cur.A2, cur.B2, false); E.mid(acc, cur, wr, wc, fr, fq); PG8_KLOOP(cur.A2, cur.B2, nA, nB, true); }
        else { PG8_KLOOP(cA, cB, nA, nB, true); }
        if (wr == 0) PG8_BAR;
        E(acc, cur, wr, wc, fr, fq);
        if (!has_next) break;
        {
#pragma unroll
            for (int a = 0; a < 2; ++a)
#pragma unroll
                for (int b = 0; b < 2; ++b)
#pragma unroll
                    for (int m = 0; m < 4; ++m)
#pragma unroll
                        for (int n = 0; n < 2; ++n) acc[a][b][m][n] = (f32x4){0.f, 0.f, 0.f, 0.f};
        }
        cur = nxt; cA = nA; cB = nB; ++ui;
        if (GATHER) {
#pragma unroll
            for (int h = 0; h < 2; ++h)
#pragma unroll
                for (int i = 0; i < 2; ++i) voA[h][i] = voN[h][i]; }
        if (wr == 1) PG8_BAR;
    }
    PG8_WAIT_V(0);
    PG8_BAR;
#undef PG8_SA
#undef PG8_SB
#undef PG8_STAGE
#undef PG8_LDA
#undef PG8_LDB
#undef PG8_MMA
#undef PG8_WAIT_V
#undef PG8_WAIT_L
#undef PG8_BAR
#undef PG8_SCHED
#undef PG8_OFFS
#undef PG8_KLOOP
}

struct EpiBf16 {
    static constexpr bool PERM = true;
    bf16_t* O; int ldc;
    __device__ __forceinline__ void mid(f32x4 (&)[2][2][4][2], const Unit&, int, int, int, int) const {}
    __device__ __forceinline__ void operator()(const f32x4 (&acc)[2][2][4][2], const Unit& u, int wr, int wc, int fr, int fq) const {
        const int row0 = u.pm * BM + wr * 64 + fr, col0 = u.pn * BM + wc * 32 + 8 * fq;
#pragma unroll
        for (int ai = 0; ai < 2; ++ai)
#pragma unroll
            for (int m = 0; m < 4; ++m) { bf16_t* rowp = O + (size_t)(row0 + ai * HALF + m * 16) * ldc + col0;
#pragma unroll
                for (int bj = 0; bj < 2; ++bj) { const f32x4 v0 = acc[ai][bj][m][0], v1 = acc[ai][bj][m][1];
                    u32x4 w; w.x = pk2(v0[0], v0[1]); w.y = pk2(v0[2], v0[3]); w.z = pk2(v1[0], v1[1]); w.w = pk2(v1[2], v1[3]);
                    *(u32x4*)(rowp + bj * HALF) = w; } }
    }
};
struct EpiProj {
    static constexpr bool PERM = true;
    unsigned char* ws;
    __device__ __forceinline__ void mid(f32x4 (&)[2][2][4][2], const Unit&, int, int, int, int) const {}
    __device__ __forceinline__ void operator()(const f32x4 (&acc)[2][2][4][2], const Unit& u, int wr, int wc, int fr, int fq) const {
        const int pn = u.pn; size_t boff; int ldc, colt, mode = 0;
        if (pn < 2) { boff = WS_CQ; ldc = 512; colt = pn * 256; }
        else if (pn == 2) { boff = WS_CKV; ldc = 256; colt = 0; }
        else if (pn == 3) { boff = WS_SM; ldc = 256; colt = 0; mode = 2; }
        else if (pn < 12) { boff = WS_MLQK; ldc = 2048; colt = (pn - 4) * 256; }
        else if (pn < 16) { boff = WS_MLV; ldc = 1024; colt = (pn - 12) * 256; }
        else if (pn < 20) { boff = WS_SIGO; ldc = 1024; colt = (pn - 16) * 256; mode = 1; }
        else if (pn < 28) { boff = WS_GA; ldc = 2048; colt = (pn - 20) * 256; mode = 1; }
        else { boff = WS_GB; ldc = 2048; colt = (pn - 28) * 256; mode = 1; }
        const int row0 = u.pm * BM + wr * 64 + fr, col0 = colt + wc * 32 + 8 * fq;
        if (mode == 2) {
            float* O = (float*)(ws + boff);
#pragma unroll
            for (int ai = 0; ai < 2; ++ai)
#pragma unroll
                for (int m = 0; m < 4; ++m) { float* rowp = O + (size_t)(row0 + ai * HALF + m * 16) * ldc + col0;
#pragma unroll
                    for (int bj = 0; bj < 2; ++bj) { *(f32x4*)(rowp + bj * HALF) = acc[ai][bj][m][0]; *(f32x4*)(rowp + bj * HALF + 4) = acc[ai][bj][m][1]; } }
        } else {
            bf16_t* O = (bf16_t*)(ws + boff);
#pragma unroll
            for (int ai = 0; ai < 2; ++ai)
#pragma unroll
                for (int m = 0; m < 4; ++m) { bf16_t* rowp = O + (size_t)(row0 + ai * HALF + m * 16) * ldc + col0;
#pragma unroll
                    for (int bj = 0; bj < 2; ++bj) { f32x4 v0 = acc[ai][bj][m][0], v1 = acc[ai][bj][m][1];
                        if (mode == 1) { v0 = (f32x4){sigm(v0[0]), sigm(v0[1]), sigm(v0[2]), sigm(v0[3])}; v1 = (f32x4){sigm(v1[0]), sigm(v1[1]), sigm(v1[2]), sigm(v1[3])}; }
                        u32x4 w; w.x = pk2(v0[0], v0[1]); w.y = pk2(v0[2], v0[3]); w.z = pk2(v1[0], v1[1]); w.w = pk2(v1[2], v1[3]);
                        *(u32x4*)(rowp + bj * HALF) = w; } }
        }
    }
};
struct EpiMix {
    static constexpr bool PERM = true;
    const bf16_t* GA; const bf16_t* GB; bf16_t* O;
    __device__ __forceinline__ void mid(f32x4 (&acc)[2][2][4][2], const Unit& u, int wr, int wc, int fr, int fq) const {
        const int row0 = u.pm * BM + wr * 64 + fr, col0 = u.pn * BM + wc * 32 + 8 * fq;
#pragma unroll
        for (int ai = 0; ai < 2; ++ai)
#pragma unroll
            for (int m = 0; m < 4; ++m) { const size_t off = (size_t)(row0 + ai * HALF + m * 16) * DM + col0;
#pragma unroll
                for (int bj = 0; bj < 2; ++bj) { const u32x4 a = *(const u32x4*)(GA + off + bj * HALF), b = *(const u32x4*)(GB + off + bj * HALF);
                    f32x4 r0 = {bflo(a.x) * __builtin_amdgcn_rcpf(bflo(b.x)), bfhi(a.x) * __builtin_amdgcn_rcpf(bfhi(b.x)), bflo(a.y) * __builtin_amdgcn_rcpf(bflo(b.y)), bfhi(a.y) * __builtin_amdgcn_rcpf(bfhi(b.y))};
                    f32x4 r1 = {bflo(a.z) * __builtin_amdgcn_rcpf(bflo(b.z)), bfhi(a.z) * __builtin_amdgcn_rcpf(bfhi(b.z)), bflo(a.w) * __builtin_amdgcn_rcpf(bflo(b.w)), bfhi(a.w) * __builtin_amdgcn_rcpf(bfhi(b.w))};
                    acc[ai][bj][m][0] = acc[ai][bj][m][0] * r0; acc[ai][bj][m][1] = acc[ai][bj][m][1] * r1;
                    asm volatile("" : "+v"(acc[ai][bj][m][0]), "+v"(acc[ai][bj][m][1]) :: "memory"); } }
    }
    __device__ __forceinline__ void operator()(const f32x4 (&acc)[2][2][4][2], const Unit& u, int wr, int wc, int fr, int fq) const {
        int row0 = u.pm * BM + wr * 64 + fr, col0 = u.pn * BM + wc * 32 + 8 * fq;
        asm volatile("" : "+v"(row0), "+v"(col0));
#pragma unroll
        for (int ai = 0; ai < 2; ++ai)
#pragma unroll
            for (int m = 0; m < 4; ++m) { const size_t off = (size_t)(row0 + ai * HALF + m * 16) * DM + col0;
#pragma unroll
                for (int bj = 0; bj < 2; ++bj) { const u32x4 b = *(const u32x4*)(GB + off + bj * HALF);
                    const f32x4 v0 = acc[ai][bj][m][0], v1 = acc[ai][bj][m][1];
                    u32x4 w; w.x = pk2(v0[0] * bflo(b.x), v0[1] * bfhi(b.x)); w.y = pk2(v0[2] * bflo(b.y), v0[3] * bfhi(b.y));
                    w.z = pk2(v1[0] * bflo(b.z), v1[1] * bfhi(b.z)); w.w = pk2(v1[2] * bflo(b.w), v1[3] * bfhi(b.w));
                    *(u32x4*)(O + off + bj * HALF) = w; }
                asm volatile("" ::: "memory"); }
    }
};
struct EpiOut {
    static constexpr bool PERM = false;
    const float* X; const float* mod; float* O;
    __device__ __forceinline__ void mid(f32x4 (&)[2][2][4][2], const Unit&, int, int, int, int) const {}
    __device__ __forceinline__ void operator()(const f32x4 (&acc)[2][2][4][2], const Unit& u, int wr, int wc, int fr, int fq) const {
        const int row0 = u.pm * BM + wr * 64 + fr, col0 = u.pn * BM + wc * 32 + 4 * fq;
        const float* gt = mod + (size_t)(u.pm >> 3) * 12288 + 4096 + col0;
        f32x4 gv[2][2];
#pragma unroll
        for (int bj = 0; bj < 2; ++bj)
#pragma unroll
            for (int n = 0; n < 2; ++n) gv[bj][n] = *(const f32x4*)(gt + bj * HALF + n * 16);
#pragma unroll
        for (int ai = 0; ai < 2; ++ai)
#pragma unroll
            for (int m = 0; m < 4; ++m) { const size_t off = (size_t)(row0 + ai * HALF + m * 16) * DM + col0;
#pragma unroll
                for (int bj = 0; bj < 2; ++bj)
#pragma unroll
                    for (int n = 0; n < 2; ++n) { const f32x4 xv = *(const f32x4*)(X + off + bj * HALF + n * 16);
                        *(f32x4*)(O + off + bj * HALF + n * 16) = xv + gv[bj][n] * acc[ai][bj][m][n]; } }
    }
};
struct EpiMoeUp {
    static constexpr bool PERM = true;
    const float* combof; bf16_t* ACT;
    __device__ __forceinline__ void mid(f32x4 (&)[2][2][4][2], const Unit&, int, int, int, int) const {}
    __device__ __forceinline__ void operator()(const f32x4 (&acc)[2][2][4][2], const Unit& u, int wr, int wc, int fr, int fq) const {
        const int col0 = u.pn * HALF + wc * 32 + 8 * fq;
#pragma unroll
        for (int ai = 0; ai < 2; ++ai)
#pragma unroll
            for (int m = 0; m < 4; ++m) { const int r = ai * HALF + wr * 64 + m * 16 + fr; const int rr = u.r0 + r;
                const float cb = (rr < u.cnt) ? combof[u.e * 8192 + rr] : 0.f;
                const f32x4 g0 = acc[ai][0][m][0], g1 = acc[ai][0][m][1], u0 = acc[ai][1][m][0], u1 = acc[ai][1][m][1];
                u32x4 w;
                w.x = pk2(g0[0] * sigm(g0[0]) * u0[0] * cb, g0[1] * sigm(g0[1]) * u0[1] * cb); w.y = pk2(g0[2] * sigm(g0[2]) * u0[2] * cb, g0[3] * sigm(g0[3]) * u0[3] * cb);
                w.z = pk2(g1[0] * sigm(g1[0]) * u1[0] * cb, g1[1] * sigm(g1[1]) * u1[1] * cb); w.w = pk2(g1[2] * sigm(g1[2]) * u1[2] * cb, g1[3] * sigm(g1[3]) * u1[3] * cb);
                *(u32x4*)(ACT + (size_t)(u.pm * BM + r) * DFF + col0) = w; }
    }
};
}

#define XB_TMO      128
#define XB_XCNT(j)  (256  + 64 * (j))
#define XB_XSUB(j)  (1280 + 64 * (j))
#define XB_XGEN(j)  (2304 + 64 * (j))
#define XB_TOP      3328
#define XB_TOPGEN   3392
#define XCD_BAR_WORDS 3456
#define XB_SPIN_CAP (1u << 18)
__device__ __forceinline__ unsigned xb_ld(unsigned* p)              { return __hip_atomic_load(p, __ATOMIC_RELAXED, __HIP_MEMORY_SCOPE_AGENT); }
__device__ __forceinline__ unsigned xb_add(unsigned* p, unsigned v) { return __hip_atomic_fetch_add(p, v, __ATOMIC_RELAXED, __HIP_MEMORY_SCOPE_AGENT); }
__device__ __forceinline__ unsigned xb_xcc_id() { return (unsigned)__builtin_amdgcn_s_getreg((3 << 11) | 20) & 0xFu; }
#define XB_SPIN(cond, bar) do { unsigned _sp = 0; while (cond) { __builtin_amdgcn_s_sleep(1); \
    if ((++_sp & 255u) == 0u) { if (xb_ld(&(bar)[XB_TMO])) break; if (_sp > XB_SPIN_CAP) { atomicAdd(&(bar)[XB_TMO], 1u); break; } } } } while (0)
struct XcdBarrier { unsigned* bar; unsigned x; volatile LAS unsigned* st; };
__device__ __forceinline__ XcdBarrier xcd_barrier_post(unsigned* bar, volatile LAS unsigned* st) {
    XcdBarrier b; b.bar = bar; b.x = xb_xcc_id(); b.st = st;
    if (threadIdx.x == 0) (void)xb_add(&bar[XB_XCNT(b.x)], 1u);
    return b;
}
__device__ __forceinline__ void xcd_barrier_complete(unsigned* bar, unsigned x, unsigned& nloc, unsigned& nx) {
    const unsigned G = gridDim.x * gridDim.y * gridDim.z;
    unsigned sum, cnt, mine, sp = 0u;
    for (;;) {
        sum = 0u; cnt = 0u; mine = 0u;
#pragma unroll
        for (unsigned j = 0; j < 16; ++j) { const unsigned c = xb_ld(&bar[XB_XCNT(j)]); sum += c; cnt += (c > 0u) ? 1u : 0u; mine = (j == x) ? c : mine; }
        if (sum == G) break;
        __builtin_amdgcn_s_sleep(1);
        if ((++sp & 255u) == 0u) { if (xb_ld(&bar[XB_TMO])) break; if (sp > XB_SPIN_CAP) { atomicAdd(&bar[XB_TMO], 1u); break; } }
    }
    nloc = mine > 0u ? mine : 1u; nx = cnt > 0u ? cnt : 1u;
}
__device__ __forceinline__ void xcd_barrier(const XcdBarrier& b) {
    asm volatile("s_waitcnt vmcnt(0)" ::: "memory");
    __syncthreads();
    if (threadIdx.x == 0) {
        unsigned* bar = b.bar;
        __builtin_amdgcn_s_waitcnt(0);
        unsigned nloc = b.st[0], nx = b.st[1];
        if (nloc == 0u) { xcd_barrier_complete(bar, b.x, nloc, nx); b.st[0] = nloc; b.st[1] = nx; }
        const unsigned old = xb_add(&bar[XB_XSUB(b.x)], 1u);
        const unsigned gen = old / nloc;
        if (old + 1u == (gen + 1u) * nloc) {
            __builtin_amdgcn_fence(__ATOMIC_RELEASE, "agent");
            asm volatile("s_waitcnt vmcnt(0)" ::: "memory");
            const unsigned og = xb_add(&bar[XB_TOP], 1u);
            const unsigned tg = og / nx;
            if (og + 1u == (tg + 1u) * nx) xb_add(&bar[XB_TOPGEN], 1u);
            else XB_SPIN(xb_ld(&bar[XB_TOPGEN]) == tg, bar);
            __builtin_amdgcn_fence(__ATOMIC_ACQUIRE, "agent");
            xb_add(&bar[XB_XGEN(b.x)], 1u);
            asm volatile("s_waitcnt vmcnt(0)" ::: "memory");
        } else {
            XB_SPIN(xb_ld(&bar[XB_XGEN(b.x)]) == gen, bar);
            __builtin_amdgcn_fence(__ATOMIC_ACQUIRE, "agent");
            asm volatile("s_waitcnt vmcnt(0)" ::: "memory");
        }
    }
    __syncthreads();
}

struct Args { const void* in[28]; float* out; unsigned char* ws; float inv_freq[32]; int ph_lo, ph_hi, li, pad; };
constexpr int PER_PHASE = 12;

template <class RowMap>
__device__ __forceinline__ void p0_transpose_item(const float* W, int K, int N, bf16_t* WT, LAS float* scr, int item, int lane, const float* kscale, const RowMap& rm) {
    const int nblk = (N + 31) / 32, kb = item / nblk, nb = item % nblk, k0 = 64 * kb, n0 = 32 * nb;
    const int kr = lane >> 3, c4 = lane & 7; const bool colok = (n0 + 4 * c4) < N;
#pragma unroll
    for (int i = 0; i < 8; ++i) { const int kk = 8 * i + kr; f32x4 v = {0.f, 0.f, 0.f, 0.f}; if (colok) { v = *(const f32x4*)(W + (size_t)(k0 + kk) * N + n0 + 4 * c4); if (kscale) v = v * kscale[k0 + kk]; }
        scr[kk * 33 + 4 * c4] = v[0]; scr[kk * 33 + 4 * c4 + 1] = v[1]; scr[kk * 33 + 4 * c4 + 2] = v[2]; scr[kk * 33 + 4 * c4 + 3] = v[3]; }
    LDS_WAIT(); asm volatile("" ::: "memory");
    const int c = lane & 7;
#pragma unroll
    for (int j = 0; j < 4; ++j) { const int n = (lane >> 3) + 8 * j; const LAS float* s = scr + (8 * c) * 33 + n;
        u32x4 o; o.x = pk2(s[0 * 33], s[1 * 33]); o.y = pk2(s[2 * 33], s[3 * 33]); o.z = pk2(s[4 * 33], s[5 * 33]); o.w = pk2(s[6 * 33], s[7 * 33]);
        if (n0 + n < N) *(GAS u32x4*)(WT + (size_t)rm(n0 + n) * K + k0 + 8 * c) = o; }
    LDS_WAIT(); asm volatile("" ::: "memory");
}
struct RmId { __device__ __forceinline__ int operator()(int n) const { return n; } };
struct RmWin { __device__ __forceinline__ int operator()(int n) const {
    if (n < 832) return n; if (n < 2880) return 1024 + (n - 832); if (n < 3904) return 3072 + (n - 2880); if (n < 4928) return 4096 + (n - 3904);
    if (n < 4936) return 832 + (n - 4928); if (n < 4944) return 840 + (n - 4936); if (n < 6992) return 5120 + (n - 4944); return 7168 + (n - 6992); } };
struct RmGate { int base; __device__ __forceinline__ int operator()(int f) const { return base + (f >> 7) * 256 + (f & 127); } };

namespace att {
constexpr int KROW = 400, VROW = 136, K_OFF = 0, V_OFF = 64 * KROW;
__device__ __forceinline__ int crow(int r, int hi) { return (r & 3) + 8 * (r >> 2) + 4 * hi; }
#define MFMA32(a, b, c) __builtin_amdgcn_mfma_f32_32x32x16_bf16((a), (b), (c), 0, 0, 0)
__device__ __forceinline__ void unit(int b, int h, int qb, const bf16_t* Q, const bf16_t* Kg, const bf16_t* Vg, bf16_t* OUTA, LAS unsigned char* lds) {
    const int tid = fresh_tid(), lane = tid & 63, ql = lane & 31, hi = lane >> 5; const int wid = __builtin_amdgcn_readfirstlane(tid >> 6);
    const size_t bh = (size_t)(b * NH + h);
    const int q0 = qb * 256 + wid * 32;
    const bf16_t* Qp = Q + (bh * SEQ + q0 + ql) * DQK;
    bf16x8 qf[12];
#pragma unroll
    for (int s = 0; s < 12; ++s) qf[s] = *(const bf16x8*)(Qp + 16 * s + 8 * hi);
    f32x16 o[4];
#pragma unroll
    for (int d = 0; d < 4; ++d) o[d] = f32x16{};
    float mrun = -1e30f, lrun = 0.f;
    const int ntile = 4 * qb + 4;
    const bf16_t* Kb = Kg + bh * SEQ * DQK; const bf16_t* Vb = Vg + bh * SEQ * DV;
    const int vhw = tid >> 5, vsp = tid & 31;
    u32x4 kreg[3], vreg[2];
#define ATT_LOAD(j) do { _Pragma("unroll") for (int i = 0; i < 3; ++i) kreg[i] = *(const u32x4*)(Kb + (size_t)(j) * 64 * DQK + (size_t)(tid + 512 * i) * 8); \
        vreg[0] = *(const u32x4*)(Vb + ((size_t)(j) * 64 + 2 * vsp) * DV + 8 * vhw); vreg[1] = *(const u32x4*)(Vb + ((size_t)(j) * 64 + 2 * vsp + 1) * DV + 8 * vhw); } while (0)
    ATT_LOAD(0);
    for (int j = 0; j < ntile; ++j) {
        __syncthreads();
#pragma unroll
        for (int i = 0; i < 3; ++i) { const int p = tid + 512 * i, row = p / 24, c = p % 24; *(LAS u32x4*)(lds + K_OFF + row * KROW + 16 * c) = kreg[i]; }
        {
            const unsigned a[4] = {vreg[0].x, vreg[0].y, vreg[0].z, vreg[0].w}, c2[4] = {vreg[1].x, vreg[1].y, vreg[1].z, vreg[1].w};
#pragma unroll
            for (int jj = 0; jj < 4; ++jj) {
                const unsigned lo = (a[jj] & 0xffffu) | (c2[jj] << 16), hi2 = (a[jj] >> 16) | (c2[jj] & 0xffff0000u);
                *(LAS unsigned*)(lds + V_OFF + (8 * vhw + 2 * jj) * VROW + 4 * vsp) = lo;
                *(LAS unsigned*)(lds + V_OFF + (8 * vhw + 2 * jj + 1) * VROW + 4 * vsp) = hi2;
            }
        }
        __syncthreads();
        if (j + 1 < ntile) ATT_LOAD(j + 1);
        if (64 * j <= q0 + 31) {
            f32x16 p0 = f32x16{}, p1 = f32x16{};
            const LAS unsigned char* kp = lds + K_OFF + ql * KROW + 16 * hi;
#pragma unroll
            for (int s = 0; s < 12; ++s) {
                const bf16x8 k0 = *(const LAS bf16x8*)(kp + 32 * s), k1 = *(const LAS bf16x8*)(kp + 32 * KROW + 32 * s);
                p0 = MFMA32(k0, qf[s], p0); p1 = MFMA32(k1, qf[s], p1);
                asm volatile("" ::: "memory");
            }
            if (64 * j + 63 > q0) {
                const int qa = q0 + ql - 64 * j;
#pragma unroll
                for (int r = 0; r < 16; ++r) { const int kv = crow(r, hi); if (kv > qa) p0[r] = -INFINITY; if (kv + 32 > qa) p1[r] = -INFINITY; }
            }
            float mx = p0[0];
#pragma unroll
            for (int r = 1; r < 16; ++r) mx = fmaxf(mx, p0[r]);
#pragma unroll
            for (int r = 0; r < 16; ++r) mx = fmaxf(mx, p1[r]);
            mx = fmaxf(mx, __shfl_xor(mx, 32));
            const float mnew = fmaxf(mrun, mx), alpha = __builtin_amdgcn_exp2f(mrun - mnew);
            float rs = 0.f;
#pragma unroll
            for (int r = 0; r < 16; ++r) { p0[r] = __builtin_amdgcn_exp2f(p0[r] - mnew); p1[r] = __builtin_amdgcn_exp2f(p1[r] - mnew); rs += p0[r] + p1[r]; }
            lrun = lrun * alpha + rs; mrun = mnew;
#pragma unroll
            for (int d = 0; d < 4; ++d)
#pragma unroll
                for (int r = 0; r < 16; ++r) o[d][r] *= alpha;
            bf16x8 pf[4];
            { u32x4 w;
              w.x = pk2(p0[0], p0[1]); w.y = pk2(p0[2], p0[3]); w.z = pk2(p0[4], p0[5]); w.w = pk2(p0[6], p0[7]); pf[0] = __builtin_bit_cast(bf16x8, w);
              w.x = pk2(p0[8], p0[9]); w.y = pk2(p0[10], p0[11]); w.z = pk2(p0[12], p0[13]); w.w = pk2(p0[14], p0[15]); pf[1] = __builtin_bit_cast(bf16x8, w);
              w.x = pk2(p1[0], p1[1]); w.y = pk2(p1[2], p1[3]); w.z = pk2(p1[4], p1[5]); w.w = pk2(p1[6], p1[7]); pf[2] = __builtin_bit_cast(bf16x8, w);
              w.x = pk2(p1[8], p1[9]); w.y = pk2(p1[10], p1[11]); w.z = pk2(p1[12], p1[13]); w.w = pk2(p1[14], p1[15]); pf[3] = __builtin_bit_cast(bf16x8, w); }
#pragma unroll
            for (int d = 0; d < 4; ++d) {
                const LAS unsigned char* vp = lds + V_OFF + (32 * d + ql) * VROW + 8 * hi;
#pragma unroll
                for (int ks = 0; ks < 4; ++ks) {
                    const u32x2 lo = *(const LAS u32x2*)(vp + 32 * ks), hi2 = *(const LAS u32x2*)(vp + 32 * ks + 16);
                    const u32x4 vv = {lo.x, lo.y, hi2.x, hi2.y};
                    o[d] = MFMA32(__builtin_bit_cast(bf16x8, vv), pf[ks], o[d]);
                }
                asm volatile("" ::: "memory");
            }
        }
    }
#undef ATT_LOAD
    const float ltot = lrun + __shfl_xor(lrun, 32), inv = 1.f / ltot;
    bf16_t* Op = OUTA + ((size_t)b * SEQ + q0 + ql) * 1024 + h * DV;
#pragma unroll
    for (int d = 0; d < 4; ++d)
#pragma unroll
        for (int g = 0; g < 4; ++g) { const int dd = 32 * d + 8 * g + 4 * hi;
            u32x2 w; w.x = pk2(o[d][4 * g] * inv, o[d][4 * g + 1] * inv); w.y = pk2(o[d][4 * g + 2] * inv, o[d][4 * g + 3] * inv);
            *(u32x2*)(Op + dd) = w; }
    __syncthreads();
}
}

namespace ml {
constexpr int QROW = 272, VROW = 136, GROW = 144, PROW = 144;
constexpr int Q_OFF = 0, K_OFF = 64 * QROW, KG_OFF = 2 * 64 * QROW, VT_OFF = KG_OFF + 128 * GROW, CT_OFF = VT_OFF + 128 * VROW, PT_OFF = CT_OFF + 160 * QROW, G_OFF = PT_OFF + 64 * PROW;
constexpr int GN = 0, GSS = 128, GDEN = 384, GDQ = 448, GU = 512, GMX = GU + 2048, GBS = GMX + 2048, GMS = GBS + 2048, GBL = GMS + 32, GML = GBL + 32, G_FLOATS = GML + 32;
static_assert(G_OFF + G_FLOATS * 4 <= RING_BYTES, "mlstm lds");
using att::crow;
#define ML_FENCE() asm volatile("" ::: "memory")
#define ML_BAR() asm volatile("s_waitcnt lgkmcnt(0)\n\ts_barrier" ::: "memory")
__device__ __forceinline__ void item(int b, int h, const Args& args, LAS unsigned char* lds) {
    unsigned char* ws = args.ws;
    const bf16_t* MQK = (const bf16_t*)(ws + WS_MQK); const bf16_t* MLV = (const bf16_t*)(ws + WS_MLV); const bf16_t* SIGO = (const bf16_t*)(ws + WS_SIGO);
    const float* SM = (const float*)(ws + WS_SM); bf16_t* HM = (bf16_t*)(ws + WS_HM);
    const float* bg = (const float*)args.in[15]; const float* gnorm = (const float*)args.in[16];
    const int tid = fresh_tid(), lane = tid & 63, tl = lane & 31, hi = lane >> 5; const int wid = __builtin_amdgcn_readfirstlane(tid >> 6);
    const int et = wid & 3, tt = wid >> 2;
    LAS float* G = (LAS float*)(lds + G_OFF);
    const size_t rowb = (size_t)b * SEQ;
    for (int i = tid; i < (160 * QROW + 64 * PROW) / 4; i += 512) ((LAS unsigned*)(lds + CT_OFF))[i] = 0u;
    if (tid < 128) G[GN + tid] = 0.f;
    { const float bi = bg[h], bf_ = bg[8 + h];
      for (int ck = wid; ck < 32; ck += 8) {
          const float gi = SM[(rowb + ck * 64 + lane) * 256 + 64 + h], gf = SM[(rowb + ck * 64 + lane) * 256 + 72 + h];
          const float fp = gf + bf_, ip = gi + bi;
          const float lf = fminf(fp, 0.f) - __logf(1.f + __expf(-fabsf(fp)));
          float bsum = lf;
#pragma unroll
          for (int o = 1; o < 64; o <<= 1) { const float v = __shfl_up(bsum, o); if (lane >= o) bsum += v; }
          const float u = ip - bsum;
          float M = u;
#pragma unroll
          for (int o = 1; o < 64; o <<= 1) { const float v = __shfl_up(M, o); if (lane >= o) M = fmaxf(M, v); }
          G[GU + ck * 64 + lane] = u; G[GMX + ck * 64 + lane] = M; G[GBS + ck * 64 + lane] = bsum;
          if (lane == 63) { G[GBL + ck] = bsum; G[GML + ck] = M; }
      } }
    __syncthreads();
    if (tid == 0) { float m = 0.f; for (int ck = 0; ck < 32; ++ck) { G[GMS + ck] = m; m = G[GBL + ck] + fmaxf(G[GML + ck], m); } }
    f32x16 cacc[2]; cacc[0] = f32x16{}; cacc[1] = f32x16{};
    const int which = tid >> 8, lo4 = tid & 15, hi4 = (tid >> 4) & 15;
    const int cc = which ? hi4 : lo4, tg = which ? lo4 : hi4;
    const int ccol = which * 1024 + h * 128 + 8 * cc;
    const int vhw = tid >> 5, vsp = tid & 31;
    const int fr = lane & 15, fq = lane >> 4;
    u32x4 craw[4], vraw[2]; u32x2 sg[4];
#define ML_LOAD(ck) do { const int t0_ = (ck) * 64; \
        _Pragma("unroll") for (int i = 0; i < 4; ++i) craw[i] = *(const u32x4*)(MQK + (rowb + t0_ + 4 * tg + i) * 2048 + ccol); \
        vraw[0] = *(const u32x4*)(MLV + (rowb + t0_ + 2 * vsp) * 1024 + h * 128 + 8 * vhw); vraw[1] = *(const u32x4*)(MLV + (rowb + t0_ + 2 * vsp + 1) * 1024 + h * 128 + 8 * vhw); } while (0)
#define ML_LOAD_SG(ck) do { const size_t or_ = (rowb + (ck) * 64 + 32 * tt + tl) * 1024 + h * 128 + 32 * et + 4 * hi; \
        _Pragma("unroll") for (int g = 0; g < 4; ++g) sg[g] = *(const u32x2*)(SIGO + or_ + 8 * g); } while (0)
    ML_LOAD(0); ML_LOAD_SG(0);
    f32x4 gn[4];
#pragma unroll
    for (int g = 0; g < 4; ++g) gn[g] = *(const f32x4*)(gnorm + h * 128 + 32 * et + 4 * hi + 8 * g);
    __syncthreads();
    for (int ck = 0; ck < 32; ++ck) {
        const int t0 = ck * 64;
        const float ms = G[GMS + ck], mmL = fmaxf(G[GML + ck], ms), decay = __expf(ms - mmL);
        ML_BAR();
        {
            const int qk_off = (which == 0) ? Q_OFF : K_OFF;
#pragma unroll
            for (int t = 0; t < 4; ++t) *(LAS u32x4*)(lds + qk_off + (4 * tg + t) * QROW + 16 * cc) = craw[t];
            if (which == 1) {
                float gs[4];
#pragma unroll
                for (int t = 0; t < 4; ++t) gs[t] = __expf(G[GU + t0 + 4 * tg + t] - mmL);
#pragma unroll
                for (int w2 = 0; w2 < 4; ++w2) {
                    const unsigned q0 = (w2 == 0) ? craw[0].x : (w2 == 1) ? craw[0].y : (w2 == 2) ? craw[0].z : craw[0].w, q1 = (w2 == 0) ? craw[1].x : (w2 == 1) ? craw[1].y : (w2 == 2) ? craw[1].z : craw[1].w;
                    const unsigned q2 = (w2 == 0) ? craw[2].x : (w2 == 1) ? craw[2].y : (w2 == 2) ? craw[2].z : craw[2].w, q3 = (w2 == 0) ? craw[3].x : (w2 == 1) ? craw[3].y : (w2 == 2) ? craw[3].z : craw[3].w;
                    u32x2 wa; wa.x = pk2(bflo(q0) * gs[0], bflo(q1) * gs[1]); wa.y = pk2(bflo(q2) * gs[2], bflo(q3) * gs[3]);
                    u32x2 wb; wb.x = pk2(bfhi(q0) * gs[0], bfhi(q1) * gs[1]); wb.y = pk2(bfhi(q2) * gs[2], bfhi(q3) * gs[3]);
                    *(LAS u32x2*)(lds + KG_OFF + (8 * cc + 2 * w2) * GROW + 8 * tg) = wa;
                    *(LAS u32x2*)(lds + KG_OFF + (8 * cc + 2 * w2 + 1) * GROW + 8 * tg) = wb;
                }
            }
            const unsigned a[4] = {vraw[0].x, vraw[0].y, vraw[0].z, vraw[0].w}, c2[4] = {vraw[1].x, vraw[1].y, vraw[1].z, vraw[1].w};
#pragma unroll
            for (int jj = 0; jj < 4; ++jj) {
                const unsigned lo = (a[jj] & 0xffffu) | (c2[jj] << 16), hi2 = (a[jj] >> 16) | (c2[jj] & 0xffff0000u);
                *(LAS unsigned*)(lds + VT_OFF + (8 * vhw + 2 * jj) * VROW + 4 * vsp) = lo;
                *(LAS unsigned*)(lds + VT_OFF + (8 * vhw + 2 * jj + 1) * VROW + 4 * vsp) = hi2;
            }
            if (tid < 64) G[GDEN + tid] = 0.f;
        }
        ML_BAR();
        if (ck + 1 < 32) ML_LOAD(ck + 1);
#pragma unroll
        for (int rnd = 0; rnd < 2; ++rnd) {
            const int idx = wid + 8 * rnd;
            if (idx < 10) {
                const int si = (idx < 4) ? idx : (idx < 7) ? idx - 4 : (idx < 9) ? idx - 7 : 0;
                const int ti = (idx < 4) ? idx : (idx < 7) ? idx - 3 : (idx < 9) ? idx - 5 : 3;
                f32x4 d = {0.f, 0.f, 0.f, 0.f};
                const LAS unsigned char* kp = lds + K_OFF + (16 * si + fr) * QROW + 16 * fq; const LAS unsigned char* qp = lds + Q_OFF + (16 * ti + fr) * QROW + 16 * fq;
#pragma unroll
                for (int kk = 0; kk < 4; ++kk) d = __builtin_amdgcn_mfma_f32_16x16x32_bf16(*(const LAS bf16x8*)(kp + 64 * kk), *(const LAS bf16x8*)(qp + 64 * kk), d, 0, 0, 0);
                const int tq = 16 * ti + fr; const float mmq = fmaxf(G[GMX + t0 + tq], ms);
                float part = 0.f;
#pragma unroll
                for (int i = 0; i < 4; ++i) { const int sq = 16 * si + 4 * fq + i; const float wv = (sq <= tq) ? __expf(G[GU + t0 + sq] - mmq) : 0.f; d[i] *= wv; part += d[i]; }
                u32x2 pw; pw.x = pk2(d[0], d[1]); pw.y = pk2(d[2], d[3]);
                *(LAS u32x2*)(lds + PT_OFF + tq * PROW + 2 * (16 * si + 4 * fq)) = pw;
                part += __shfl_xor(part, 16); part += __shfl_xor(part, 32);
                if (fq == 0) __hip_atomic_fetch_add((float*)(G + GDEN + tq), part, __ATOMIC_RELAXED, __HIP_MEMORY_SCOPE_WORKGROUP);
            }
        }
        const int t = 32 * tt + tl;
        bf16x8 qf[8];
#pragma unroll
        for (int ks = 0; ks < 8; ++ks) qf[ks] = *(const LAS bf16x8*)(lds + Q_OFF + t * QROW + 32 * ks + 16 * hi);
        ML_FENCE();
        f32x16 qc = f32x16{};
#pragma unroll
        for (int ks = 0; ks < 8; ++ks) { const bf16x8 cf = *(const LAS bf16x8*)(lds + CT_OFF + (32 * et + tl) * QROW + 32 * ks + 16 * hi); qc = MFMA32(cf, qf[ks], qc); if ((ks & 3) == 3) ML_FENCE(); }
        if (et == 0) {
            f32x16 qn = f32x16{};
#pragma unroll
            for (int ks = 0; ks < 8; ++ks) { const bf16x8 cf = *(const LAS bf16x8*)(lds + CT_OFF + (128 + tl) * QROW + 32 * ks + 16 * hi); qn = MFMA32(cf, qf[ks], qn); if ((ks & 3) == 3) ML_FENCE(); }
            if (hi == 0) G[GDQ + t] = qn[0];
        }
        const float mm_t = fmaxf(G[GMX + t0 + t], ms), a_t = __expf(ms - mm_t), em_t = __expf(-(G[GBS + t0 + t] + mm_t));
        ML_BAR();
        f32x16 hacc = f32x16{};
#pragma unroll
        for (int ks = 0; ks < 4; ++ks) {
            if (ks < 2 * tt + 2) {
                const LAS unsigned char* vp = lds + VT_OFF + (32 * et + tl) * VROW + 32 * ks + 16 * hi;
                const u32x2 lo = *(const LAS u32x2*)(vp), hi2 = *(const LAS u32x2*)(vp + 8);
                const u32x4 vv = {lo.x, lo.y, hi2.x, hi2.y};
                const bf16x8 pf = *(const LAS bf16x8*)(lds + PT_OFF + t * PROW + 32 * ks + 16 * hi);
                hacc = MFMA32(__builtin_bit_cast(bf16x8, vv), pf, hacc);
            }
        }
        const float den = G[GDEN + t] + a_t * G[GDQ + t];
        const float rden = 1.f / fmaxf(fabsf(den), em_t);
        float ssq = 0.f;
#pragma unroll
        for (int r = 0; r < 16; ++r) { hacc[r] = (hacc[r] + a_t * qc[r]) * rden; ssq += hacc[r] * hacc[r]; }
        ssq += __shfl_xor(ssq, 32);
        if (hi == 0) G[GSS + t * 4 + et] = ssq;
        const size_t orow = (rowb + t0 + t) * 1024 + h * 128 + 32 * et + 4 * hi;
        ML_BAR();
        {
            const float tot = G[GSS + t * 4] + G[GSS + t * 4 + 1] + G[GSS + t * 4 + 2] + G[GSS + t * 4 + 3];
            const float rstd = 1.f / sqrtf(tot * (1.f / 128.f) + EPS);
#pragma unroll
            for (int g = 0; g < 4; ++g) { u32x2 w;
                w.x = pk2(hacc[4 * g] * rstd * gn[g][0] * bflo(sg[g].x), hacc[4 * g + 1] * rstd * gn[g][1] * bfhi(sg[g].x));
                w.y = pk2(hacc[4 * g + 2] * rstd * gn[g][2] * bflo(sg[g].y), hacc[4 * g + 3] * rstd * gn[g][3] * bfhi(sg[g].y));
                *(u32x2*)(HM + orow + 8 * g) = w; }
        }
        if (ck + 1 < 32) ML_LOAD_SG(ck + 1);
        ML_FENCE();
#pragma unroll
        for (int i = 0; i < 2; ++i) {
#pragma unroll
            for (int r = 0; r < 16; ++r) cacc[i][r] *= decay;
#pragma unroll
            for (int ks = 0; ks < 4; ++ks) {
                const LAS unsigned char* vp = lds + VT_OFF + (32 * et + tl) * VROW + 32 * ks + 16 * hi;
                const u32x2 lo = *(const LAS u32x2*)(vp), hi2 = *(const LAS u32x2*)(vp + 8);
                const u32x4 vv = {lo.x, lo.y, hi2.x, hi2.y};
                const bf16x8 kg = *(const LAS bf16x8*)(lds + KG_OFF + (32 * (2 * tt + i) + tl) * GROW + 32 * ks + 16 * hi);
                cacc[i] = MFMA32(__builtin_bit_cast(bf16x8, vv), kg, cacc[i]);
            }
#pragma unroll
            for (int r = 0; r < 16; r += 2) { const unsigned pw = pk2(cacc[i][r], cacc[i][r + 1]); LAS unsigned char* cp = lds + CT_OFF + (32 * et + crow(r, hi)) * QROW + 2 * (32 * (2 * tt + i) + tl);
                *(LAS bf16_t*)cp = (bf16_t)pw; *(LAS bf16_t*)(cp + QROW) = (bf16_t)(pw >> 16); }
            ML_FENCE();
        }
        if (tid < 128) { float s = 0.f;
#pragma unroll
            for (int i = 0; i < 8; ++i) { const u32x4 kv = *(const LAS u32x4*)(lds + KG_OFF + tid * GROW + 16 * i);
                s += bflo(kv.x) + bfhi(kv.x) + bflo(kv.y) + bfhi(kv.y) + bflo(kv.z) + bfhi(kv.z) + bflo(kv.w) + bfhi(kv.w); }
            const float nn = decay * G[GN + tid] + s; G[GN + tid] = nn; *(LAS bf16_t*)(lds + CT_OFF + 128 * QROW + 2 * tid) = (bf16_t)f2bf(nn); }
    }
#undef ML_LOAD
#undef ML_LOAD_SG
    __syncthreads();
}
}

constexpr int BG_GU_WITEMS = 32 * 1024, BG_D_WITEMS = 32 * 512, BG_BLOCK_ITEMS = (BG_GU_WITEMS + BG_D_WITEMS) / 8;
__device__ __forceinline__ void bg_item(const Args& args, LAS float* scr, int it, int wave, int lane) {
    unsigned char* ws = args.ws;
    const float* w_ge = (const float*)args.in[25]; const float* w_ue = (const float*)args.in[26]; const float* w_de = (const float*)args.in[27];
    int r = it * 8 + wave;
    if (r < BG_GU_WITEMS) { const int e = r >> 10, rr = r & 1023;
        if (rr < 512) p0_transpose_item(w_ge + (size_t)e * DM * DFF, DM, DFF, (bf16_t*)(ws + WS_WGU), scr, rr, lane, nullptr, RmGate{e * 1024});
        else p0_transpose_item(w_ue + (size_t)e * DM * DFF, DM, DFF, (bf16_t*)(ws + WS_WGU), scr, rr - 512, lane, nullptr, RmGate{e * 1024 + 128});
    } else { r -= BG_GU_WITEMS; const int e = r >> 9, rr = r & 511;
        p0_transpose_item(w_de + (size_t)e * DFF * DM, DFF, DM, (bf16_t*)(ws + WS_WD) + (size_t)e * DM * DFF, scr, rr, lane, nullptr, RmId{}); }
}
__device__ __forceinline__ void bg_drain(const Args& args, LAS unsigned char* lds, int limit) {
    const int tid = fresh_tid(), lane = tid & 63; const int wave = __builtin_amdgcn_readfirstlane(tid >> 6);
    gu32* ctl = (gu32*)(args.ws + WS_CTL);
    LAS int* qslot = (LAS int*)(lds + MISC_OFF + 96);
    LAS float* scr = (LAS float*)(lds + wave * 16384);
    for (;;) {
        __syncthreads();
        if (tid == 0) { int it = limit; if ((int)__hip_atomic_load(ctl + CW_BGQ, RLX_AGENT) < limit) it = (int)__hip_atomic_fetch_add(ctl + CW_BGQ, 1u, RLX_AGENT); *qslot = it; }
        __syncthreads();
        const int it = *qslot;
        if (it >= limit) break;
        bg_item(args, scr, it, wave, lane);
    }
}
__device__ __forceinline__ void bg_slack(const Args& args, LAS unsigned char* lds, int ph, int G) {
    const int tid = fresh_tid(), lane = tid & 63; const int wave = __builtin_amdgcn_readfirstlane(tid >> 6);
    gu32* ctl = (gu32*)(args.ws + WS_CTL);
    LAS int* qslot = (LAS int*)(lds + MISC_OFF + 96);
    LAS float* scr = (LAS float*)(lds + wave * 16384);
    __syncthreads();
    if (tid == 0) (void)__hip_atomic_fetch_add(ctl + CW_FGDONE + 64 * ph, 1u, RLX_AGENT);
    for (;;) {
        __syncthreads();
        if (tid == 0) { int it = BG_BLOCK_ITEMS;
            if ((int)__hip_atomic_load(ctl + CW_FGDONE + 64 * ph, RLX_AGENT) < G && (int)__hip_atomic_load(ctl + CW_BGQ, RLX_AGENT) < BG_BLOCK_ITEMS) it = (int)__hip_atomic_fetch_add(ctl + CW_BGQ, 1u, RLX_AGENT);
            *qslot = it; }
        __syncthreads();
        const int it = *qslot;
        if (it >= BG_BLOCK_ITEMS) break;
        bg_item(args, scr, it, wave, lane);
    }
}

__global__ void __launch_bounds__(NWAVES * 64, 2) mk_fwd(Args args) {
    extern __shared__ __attribute__((aligned(16))) unsigned char lds_raw[];
    LAS unsigned char* lds = (LAS unsigned char*)lds_raw;
    volatile LAS unsigned* MISC = (volatile LAS unsigned*)(lds + MISC_OFF);
    const int G = gridDim.x; const int bx = blockIdx.x; const int vcu = (G % 8 == 0) ? (bx % 8) * (G / 8) + bx / 8 : bx;
    unsigned char* ws = args.ws;
    gu32* ctl = (gu32*)(ws + WS_CTL);
    for (int u = threadIdx.x; u < (LDS_BYTES - LDSCTL_OFF) / 4; u += NWAVES * 64) ((LAS unsigned*)(lds + LDSCTL_OFF))[u] = 0u;
    __syncthreads();
    XcdBarrier bar; bar.bar = (unsigned*)(ctl + CW_BAR); bar.x = 0; bar.st = nullptr;
    if (MK_N_LAUNCHES != PER_PHASE) bar = xcd_barrier_post((unsigned*)(ctl + CW_BAR), MISC + 8);
#define GRID_BAR() do { if (MK_N_LAUNCHES != PER_PHASE) xcd_barrier(bar); } while (0)
    const int lo = args.ph_lo, hi = args.ph_hi;
#ifndef PH_MASK
#define PH_MASK 0xfff
#endif
#define IN(k) (((PH_MASK >> (k)) & 1) && lo <= (k) && (k) < hi)
#define BOTH(k) (IN(k) && IN((k) + 1))
#ifndef DUP_MASK
#define DUP_MASK 0
#endif
#define NREP(k) (1 + ((DUP_MASK >> (k)) & 1))
#define LASTREP(k) (rep + 1 == NREP(k))
    const int NGW = G * NWAVES;
#define PHASE_IDS() const int tid = fresh_tid(); const int lane = tid & 63; const int wave = __builtin_amdgcn_readfirstlane(tid >> 6); const int gw = vcu * NWAVES + wave; (void)lane; (void)gw
    float* MOD = (float*)(ws + WS_MOD);

    for (int rep = 0; rep < NREP(0); ++rep) if (IN(0)) {
        PHASE_IDS();
        const float* c_in = (const float*)args.in[1]; const float* w_ada = (const float*)args.in[3]; const float* b_ada = (const float*)args.in[4];
        if (bx < 192) {
            LAS float* scond = (LAS float*)lds; LAS float* part = (LAS float*)(lds + 32768);
            for (int i = tid; i < NB * DM; i += 512) { const float v = c_in[i]; scond[i] = v * sigm(v); }
            __syncthreads();
            const int n0 = 64 * bx, rs = lane >> 4, c4 = lane & 15;
            f32x4 a0 = {0.f, 0.f, 0.f, 0.f}, a1 = a0, a2 = a0, a3 = a0;
#pragma unroll 8
            for (int it = 0; it < 64; ++it) { const int k = 256 * wave + 4 * it + rs; const f32x4 wv = *(const f32x4*)(w_ada + (size_t)k * 12288 + n0 + 4 * c4);
                a0 += wv * scond[k]; a1 += wv * scond[2048 + k]; a2 += wv * scond[4096 + k]; a3 += wv * scond[6144 + k]; }
#pragma unroll
            for (int j = 0; j < 4; ++j) { a0[j] += __shfl_xor(a0[j], 16); a0[j] += __shfl_xor(a0[j], 32); a1[j] += __shfl_xor(a1[j], 16); a1[j] += __shfl_xor(a1[j], 32);
                a2[j] += __shfl_xor(a2[j], 16); a2[j] += __shfl_xor(a2[j], 32); a3[j] += __shfl_xor(a3[j], 16); a3[j] += __shfl_xor(a3[j], 32); }
            if (rs == 0) { *(LAS f32x4*)(part + (wave * 4 + 0) * 64 + 4 * c4) = a0; *(LAS f32x4*)(part + (wave * 4 + 1) * 64 + 4 * c4) = a1;
                *(LAS f32x4*)(part + (wave * 4 + 2) * 64 + 4 * c4) = a2; *(LAS f32x4*)(part + (wave * 4 + 3) * 64 + 4 * c4) = a3; }
            __syncthreads();
            if (tid < 256) { const int b = tid >> 6, col = tid & 63; float s = b_ada[n0 + col];
#pragma unroll
                for (int w = 0; w < 8; ++w) s += part[(w * 4 + b) * 64 + col];
                MOD[b * 12288 + n0 + col] = s; }
            __syncthreads();
        }
        LAS float* scr = (LAS float*)(lds + wave * 16384);
        const float* w_in = (const float*)args.in[6]; const float* w_uq = (const float*)args.in[8]; const float* w_ukv = (const float*)args.in[10];
        const float* w_pa = (const float*)args.in[17]; const float* w_pb = (const float*)args.in[18]; const float* w_out = (const float*)args.in[19];
        const float* qag = (const float*)args.in[7]; const float* kvag = (const float*)args.in[9];
        constexpr int I_IN = 32 * 283, I_UQ = 8 * 48, I_UKV = 4 * 64, I_P = 16 * 64, I_O = 32 * 64, I_G = 32 * 16, I_D = 8 * 64;
        constexpr int NITEMS = I_IN + I_UQ + I_UKV + 2 * I_P + I_O;
        { LAS int* qslot = (LAS int*)(lds + MISC_OFF + 96);
          for (;;) {
            __syncthreads();
            if (tid == 0) *qslot = (int)__hip_atomic_fetch_add(ctl + CW_P0Q, 1u, RLX_AGENT);
            __syncthreads();
            const int bit = *qslot;
            if (bit * 8 >= NITEMS) break;
            int r = bit * 8 + wave;
            if (r >= NITEMS) continue;
            if (r < I_IN) { p0_transpose_item(w_in, DM, INC, (bf16_t*)(ws + WS_WIN), scr, r, lane, nullptr, RmWin{}); continue; } r -= I_IN;
            if (r < I_UQ) { p0_transpose_item(w_uq, QL, 1536, (bf16_t*)(ws + WS_WUQ), scr, r, lane, qag, RmId{}); continue; } r -= I_UQ;
            if (r < I_UKV) { p0_transpose_item(w_ukv, KVL, 2048, (bf16_t*)(ws + WS_WUKV), scr, r, lane, kvag, RmId{}); continue; } r -= I_UKV;
            if (r < I_P) { p0_transpose_item(w_pa, 1024, DM, (bf16_t*)(ws + WS_WPA), scr, r, lane, nullptr, RmId{}); continue; } r -= I_P;
            if (r < I_P) { p0_transpose_item(w_pb, 1024, DM, (bf16_t*)(ws + WS_WPB), scr, r, lane, nullptr, RmId{}); continue; } r -= I_P;
            p0_transpose_item(w_out, DM, DM, (bf16_t*)(ws + WS_WOUT), scr, r, lane, nullptr, RmId{});
          } }
        { const float* wgp = (const float*)args.in[21]; const float* wrp = (const float*)args.in[23]; bf16_t* whi = (bf16_t*)(ws + WS_WRT); bf16_t* wlo = whi + 48 * DM;
          for (int i = gw * 64 + lane; i < 48 * 256; i += NGW * 64) { const int o = i >> 8, k0 = (i & 255) * 8; float v[8];
#pragma unroll
              for (int e = 0; e < 8; ++e) v[e] = (o < 32) ? wrp[(size_t)(k0 + e) * 32 + o] : (o < 36) ? wgp[(size_t)(k0 + e) * 4 + (o - 32)] : 0.f;
              unsigned h[8], l[8];
#pragma unroll
              for (int e = 0; e < 8; ++e) { h[e] = f2bf(v[e]); l[e] = f2bf(v[e] - __builtin_bit_cast(float, h[e] << 16)); }
              *(u32x4*)(whi + (size_t)o * DM + k0) = (u32x4){h[0] | (h[1] << 16), h[2] | (h[3] << 16), h[4] | (h[5] << 16), h[6] | (h[7] << 16)};
              *(u32x4*)(wlo + (size_t)o * DM + k0) = (u32x4){l[0] | (l[1] << 16), l[2] | (l[3] << 16), l[4] | (l[5] << 16), l[6] | (l[7] << 16)}; } }
        { u32x4* z = (u32x4*)(ws + WS_WIN + (size_t)848 * DM * 2); const int n16 = 176 * DM * 2 / 16;
          for (int i = gw * 64 + lane; i < n16; i += NGW * 64) z[i] = (u32x4){0u, 0u, 0u, 0u}; }
        if (BOTH(0) || !LASTREP(0)) GRID_BAR();
    }

    for (int rep = 0; rep < NREP(1); ++rep) if (IN(1)) {
        PHASE_IDS();
        const float* x = (const float*)args.in[0]; const float* g = (const float*)args.in[5]; bf16_t* H = (bf16_t*)(ws + WS_H);
        for (int m = gw; m < MTOK; m += NGW) {
            const int b = m >> 11; const f32x4* xr = (const f32x4*)(x + (size_t)m * DM) + lane;
            f32x4 v[8]; float s = 0.f;
#pragma unroll
            for (int j = 0; j < 8; ++j) { v[j] = xr[64 * j]; s += (v[j][0] * v[j][0] + v[j][1] * v[j][1]) + (v[j][2] * v[j][2] + v[j][3] * v[j][3]); }
            const float rstd = 1.f / sqrtf(wave_sum(s) * (1.f / DM) + EPS);
            unsigned long long* o8 = (unsigned long long*)(H + (size_t)m * DM) + lane;
#pragma unroll
            for (int j = 0; j < 8; ++j) { const int k = 4 * (lane + 64 * j); const f32x4 gv = *(const f32x4*)(g + k), sh = *(const f32x4*)(MOD + b * 12288 + k), sc = *(const f32x4*)(MOD + b * 12288 + 2048 + k);
                const f32x4 hv = v[j] * rstd * gv * (sc + 1.f) + sh;
                o8[64 * j] = (unsigned long long)pk2(hv[0], hv[1]) | ((unsigned long long)pk2(hv[2], hv[3]) << 32); }
        }
        { const float* g2 = (const float*)args.in[20]; float* GS2 = (float*)(ws + WS_GS2);
          for (int i = gw * 64 + lane; i < NB * DM; i += NGW * 64) { const int b = i >> 11, k = i & 2047; GS2[i] = g2[k] * (1.f + MOD[b * 12288 + 8192 + k]); }
          if (gw < 144) { const int b = gw / 36, o = gw % 36; const float* wgp = (const float*)args.in[21]; const float* wrp = (const float*)args.in[23];
              float a = 0.f;
              for (int k = lane; k < DM; k += 64) a += MOD[b * 12288 + 6144 + k] * ((o < 32) ? wrp[(size_t)k * 32 + o] : wgp[(size_t)k * 4 + (o - 32)]);
              a = wave_sum(a);
              if (lane == 0) ((float*)(ws + WS_CVEC))[b * 48 + o] = a + ((o < 32) ? ((const float*)args.in[24])[o] : ((const float*)args.in[22])[o - 32]); } }
        if (BOTH(1) || !LASTREP(1)) GRID_BAR();
    }

    for (int rep = 0; rep < NREP(2); ++rep) if (IN(2)) {
        pg8::StaticSched S; S.T.init(MTOK, INCP, G, bx); S.A = (const char*)(ws + WS_H); S.B = (const char*)(ws + WS_WIN); S.K = DM;
        pg8::EpiProj E{ws};
        pg8::gemm_phase<pg8::EpiProj, pg8::StaticSched, false>(lds, DM, S, E);
        if (LASTREP(2)) bg_slack(args, lds, 2, G);
        if (BOTH(2) || !LASTREP(2)) GRID_BAR();
    }

    for (int rep = 0; rep < NREP(3); ++rep) if (IN(3)) {
        { pg8::StaticSched S; S.T.init(MTOK, 1536, G, bx); S.A = (const char*)(ws + WS_CQ); S.B = (const char*)(ws + WS_WUQ); S.K = QL;
          pg8::EpiBf16 E{(bf16_t*)(ws + WS_QRAW), 1536};
          pg8::gemm_phase<pg8::EpiBf16, pg8::StaticSched, false>(lds, QL, S, E); }
        { pg8::StaticSched S; S.T.init(MTOK, 2048, G, bx); S.A = (const char*)(ws + WS_CKV); S.B = (const char*)(ws + WS_WUKV); S.K = KVL;
          pg8::EpiBf16 E{(bf16_t*)(ws + WS_KVRAW), 2048};
          pg8::gemm_phase<pg8::EpiBf16, pg8::StaticSched, false>(lds, KVL, S, E); }
        if (LASTREP(3)) bg_slack(args, lds, 3, G);
        if (BOTH(3) || !LASTREP(3)) GRID_BAR();
    }

    for (int rep = 0; rep < NREP(4); ++rep) if (IN(4)) {
        PHASE_IDS();
        const bf16_t* CQ = (const bf16_t*)(ws + WS_CQ); const bf16_t* CKV = (const bf16_t*)(ws + WS_CKV); const float* SM = (const float*)(ws + WS_SM);
        const bf16_t* QRAW = (const bf16_t*)(ws + WS_QRAW); const bf16_t* KVRAW = (const bf16_t*)(ws + WS_KVRAW);
        bf16_t* Qo = (bf16_t*)(ws + WS_Q); bf16_t* Ko = (bf16_t*)(ws + WS_K); bf16_t* Vo = (bf16_t*)(ws + WS_V);
        const int* pos = (const int*)args.in[2]; const float* gq = (const float*)args.in[11]; const float* gk = (const float*)args.in[12];
        const int hh = lane >> 3, jj = lane & 7;
        f32x4 gqv[3][2], gkv[3][2];
#pragma unroll
        for (int c = 0; c < 3; ++c) { gqv[c][0] = *(const f32x4*)(gq + 64 * c + 8 * jj); gqv[c][1] = *(const f32x4*)(gq + 64 * c + 8 * jj + 4);
            gkv[c][0] = *(const f32x4*)(gk + 64 * c + 8 * jj); gkv[c][1] = *(const f32x4*)(gk + 64 * c + 8 * jj + 4); }
        float invf[8];
#pragma unroll
        for (int e = 0; e < 8; ++e) invf[e] = args.inv_freq[8 * (jj & 3) + e];
        for (int tok = gw; tok < MTOK; tok += NGW) {
            const int b = tok >> 11, sq_ = tok & 2047;
            float scq, sckv;
            { const u32x4 w = *(const u32x4*)(CQ + (size_t)tok * QL + 8 * lane); float a = 0.f; a += bflo(w.x) * bflo(w.x) + bfhi(w.x) * bfhi(w.x); a += bflo(w.y) * bflo(w.y) + bfhi(w.y) * bfhi(w.y);
              a += bflo(w.z) * bflo(w.z) + bfhi(w.z) * bfhi(w.z); a += bflo(w.w) * bflo(w.w) + bfhi(w.w) * bfhi(w.w); scq = 1.f / sqrtf(wave_sum(a) * (1.f / QL) + EPS); }
            { const u32x2 w = *(const u32x2*)(CKV + (size_t)tok * KVL + 4 * lane); float a = bflo(w.x) * bflo(w.x) + bfhi(w.x) * bfhi(w.x) + bflo(w.y) * bflo(w.y) + bfhi(w.y) * bfhi(w.y);
              sckv = 1.f / sqrtf(wave_sum(a) * (1.f / KVL) + EPS); }
            const u32x4 q0 = *(const u32x4*)(QRAW + (size_t)tok * 1536 + hh * DQK + 8 * jj), q1 = *(const u32x4*)(QRAW + (size_t)tok * 1536 + hh * DQK + 64 + 8 * jj), q2 = *(const u32x4*)(QRAW + (size_t)tok * 1536 + hh * DQK + 128 + 8 * jj);
            const u32x4 k0 = *(const u32x4*)(KVRAW + (size_t)tok * 2048 + hh * 256 + 8 * jj), k1 = *(const u32x4*)(KVRAW + (size_t)tok * 2048 + hh * 256 + 64 + 8 * jj);
            const u32x4 v0 = *(const u32x4*)(KVRAW + (size_t)tok * 2048 + hh * 256 + 128 + 16 * jj), v1 = *(const u32x4*)(KVRAW + (size_t)tok * 2048 + hh * 256 + 128 + 16 * jj + 8);
            const f32x4 pe0 = *(const f32x4*)(SM + (size_t)tok * 256 + 8 * jj), pe1 = *(const f32x4*)(SM + (size_t)tok * 256 + 8 * jj + 4);
            float cs[8], sn[8];
            { const float fpos = (float)pos[tok];
#pragma unroll
              for (int e = 0; e < 8; ++e) { const float ang = fpos * invf[e]; const float n = rintf(ang * 0.15915494309189535f);
                float r = fmaf(-n, 6.28125f, ang); r = fmaf(-n, C2PI_2, r); r = fmaf(-n, C2PI_3, r);
                const float rev = r * 0.15915494309189535f; cs[e] = __builtin_amdgcn_cosf(rev); sn[e] = __builtin_amdgcn_sinf(rev); } }
            float x[3][8], kk[3][8];
#define UNPK(dst, src_) do { const u32x4 t_ = (src_); dst[0] = bflo(t_.x); dst[1] = bfhi(t_.x); dst[2] = bflo(t_.y); dst[3] = bfhi(t_.y); dst[4] = bflo(t_.z); dst[5] = bfhi(t_.z); dst[6] = bflo(t_.w); dst[7] = bfhi(t_.w); } while (0)
            UNPK(x[0], q0); UNPK(x[1], q1); UNPK(x[2], q2); UNPK(kk[0], k0); UNPK(kk[1], k1);
#pragma unroll
            for (int e = 0; e < 4; ++e) { kk[2][e] = pe0[e]; kk[2][4 + e] = pe1[e]; }
            float sq = 0.f, sk = 0.f, sp = 0.f;
#pragma unroll
            for (int e = 0; e < 8; ++e) { sq += x[0][e] * x[0][e] + x[1][e] * x[1][e] + x[2][e] * x[2][e]; sk += kk[0][e] * kk[0][e] + kk[1][e] * kk[1][e]; sp += kk[2][e] * kk[2][e]; }
            sk = sckv * sckv * sk + sp;
            sq += __shfl_xor(sq, 1); sk += __shfl_xor(sk, 1); sq += __shfl_xor(sq, 2); sk += __shfl_xor(sk, 2); sq += __shfl_xor(sq, 4); sk += __shfl_xor(sk, 4);
            const float rq = scq / sqrtf(scq * scq * sq * (1.f / DQK) + EPS) * QSCALE, rk = 1.f / sqrtf(sk * (1.f / DQK) + EPS);
            const float rkn = rk * sckv;
#pragma unroll
            for (int c = 0; c < 3; ++c)
#pragma unroll
                for (int e = 0; e < 8; ++e) { x[c][e] *= rq * gqv[c][e >> 2][e & 3]; kk[c][e] *= ((c < 2) ? rkn : rk) * gkv[c][e >> 2][e & 3]; }
#pragma unroll
            for (int e = 0; e < 8; ++e) { const float py = __shfl_xor(x[2][e], 4), pz = __shfl_xor(kk[2][e], 4);
                x[2][e] = (jj < 4) ? (x[2][e] * cs[e] - py * sn[e]) : (py * sn[e] + x[2][e] * cs[e]);
                kk[2][e] = (jj < 4) ? (kk[2][e] * cs[e] - pz * sn[e]) : (pz * sn[e] + kk[2][e] * cs[e]); }
            const size_t bhs = ((size_t)(b * NH + hh) * SEQ + sq_);
#pragma unroll
            for (int c = 0; c < 3; ++c) { u32x4 w; w.x = pk2(x[c][0], x[c][1]); w.y = pk2(x[c][2], x[c][3]); w.z = pk2(x[c][4], x[c][5]); w.w = pk2(x[c][6], x[c][7]);
                *(u32x4*)(Qo + bhs * DQK + 64 * c + 8 * jj) = w;
                w.x = pk2(kk[c][0], kk[c][1]); w.y = pk2(kk[c][2], kk[c][3]); w.z = pk2(kk[c][4], kk[c][5]); w.w = pk2(kk[c][6], kk[c][7]);
                *(u32x4*)(Ko + bhs * DQK + 64 * c + 8 * jj) = w; }
            { float vv[8]; u32x4 w; UNPK(vv, v0); w.x = pk2(vv[0] * sckv, vv[1] * sckv); w.y = pk2(vv[2] * sckv, vv[3] * sckv); w.z = pk2(vv[4] * sckv, vv[5] * sckv); w.w = pk2(vv[6] * sckv, vv[7] * sckv);
              *(u32x4*)(Vo + bhs * DV + 16 * jj) = w;
              UNPK(vv, v1); w.x = pk2(vv[0] * sckv, vv[1] * sckv); w.y = pk2(vv[2] * sckv, vv[3] * sckv); w.z = pk2(vv[4] * sckv, vv[5] * sckv); w.w = pk2(vv[6] * sckv, vv[7] * sckv);
              *(u32x4*)(Vo + bhs * DV + 16 * jj + 8) = w; }
#undef UNPK
        }
        { const bf16_t* MLQK = (const bf16_t*)(ws + WS_MLQK); bf16_t* MQK = (bf16_t*)(ws + WS_MQK);
          const float* conv_w = (const float*)args.in[13]; const float* conv_b = (const float*)args.in[14];
          for (int it = gw * 64 + lane; it < (MTOK / 4) * 256; it += NGW * 64) {
              const int cch = it & 255, tq = it >> 8, col = 8 * cch, tok0 = 4 * tq, sl = tok0 & 2047;
              u32x4 raw[7];
#pragma unroll
              for (int i = 0; i < 7; ++i) raw[i] = (sl - 3 + i >= 0) ? *(const u32x4*)(MLQK + (size_t)(tok0 - 3 + i) * 2048 + col) : (u32x4){0u, 0u, 0u, 0u};
              f32x4 wv[4][2], bv[2];
#pragma unroll
              for (int j = 0; j < 4; ++j) { wv[j][0] = *(const f32x4*)(conv_w + j * 2048 + col); wv[j][1] = *(const f32x4*)(conv_w + j * 2048 + col + 4); }
              bv[0] = *(const f32x4*)(conv_b + col); bv[1] = *(const f32x4*)(conv_b + col + 4);
              const float ksc = (col < 1024) ? 1.f : 0.08838834764831845f;
              unsigned ow[4][4];
#pragma unroll
              for (int w2 = 0; w2 < 4; ++w2) {
                  float xa[7], xb[7];
#pragma unroll
                  for (int i = 0; i < 7; ++i) { const unsigned q = (w2 == 0) ? raw[i].x : (w2 == 1) ? raw[i].y : (w2 == 2) ? raw[i].z : raw[i].w; xa[i] = bflo(q); xb[i] = bfhi(q); }
#pragma unroll
                  for (int t = 0; t < 4; ++t) { float sa = bv[w2 >> 1][(2 * w2) & 3], sb = bv[w2 >> 1][(2 * w2 + 1) & 3];
#pragma unroll
                      for (int j = 0; j < 4; ++j) { sa += wv[j][w2 >> 1][(2 * w2) & 3] * xa[t + j]; sb += wv[j][w2 >> 1][(2 * w2 + 1) & 3] * xb[t + j]; }
                      ow[t][w2] = pk2(sa * sigm(sa) * ksc, sb * sigm(sb) * ksc); } }
#pragma unroll
              for (int t = 0; t < 4; ++t) *(u32x4*)(MQK + (size_t)(tok0 + t) * 2048 + col) = (u32x4){ow[t][0], ow[t][1], ow[t][2], ow[t][3]};
          } }
        if (BOTH(4) || !LASTREP(4)) GRID_BAR();
    }

    for (int rep = 0; rep < NREP(5); ++rep) if (IN(5)) {
        PHASE_IDS();
#ifndef P4_PROBE
#define P4_PROBE 0
#endif
#ifndef NO_ML
        if (bx < 32) {
            if (!(P4_PROBE == 2 && !LASTREP(5)))
            ml::item(bx >> 3, bx & 7, args, lds);
        } else
#endif
#ifndef NO_ATT
        {
            LAS int* qslot = (LAS int*)(lds + MISC_OFF + 64);
            if (!(P4_PROBE == 1 && !LASTREP(5)))
            for (;;) {
                __syncthreads();
                if (tid == 0) *qslot = (int)__hip_atomic_fetch_add(ctl + CW_ATTQ + 64 * rep, 1u, RLX_AGENT);
                __syncthreads();
                const int it = *qslot;
                if (it >= 256) break;
                const int qb = 7 - (it >> 5), bh = it & 31;
                att::unit(bh >> 3, bh & 7, qb, (const bf16_t*)(ws + WS_Q), (const bf16_t*)(ws + WS_K), (const bf16_t*)(ws + WS_V), (bf16_t*)(ws + WS_OUTA), lds);
            }
        }
#else
        {}
#endif
        if (LASTREP(5)) bg_slack(args, lds, 5, G);
        if (BOTH(5) || !LASTREP(5)) GRID_BAR();
    }

    for (int rep = 0; rep < NREP(6); ++rep) if (IN(6)) {
        pg8::ChainSched S; S.T.init(MTOK, DM, G, bx); S.A0 = (const char*)(ws + WS_OUTA); S.B0 = (const char*)(ws + WS_WPA); S.A1 = (const char*)(ws + WS_HM); S.B1 = (const char*)(ws + WS_WPB); S.K = 1024;
        pg8::EpiMix E{(const bf16_t*)(ws + WS_GA), (const bf16_t*)(ws + WS_GB), (bf16_t*)(ws + WS_MIXED)};
        pg8::gemm_phase<pg8::EpiMix, pg8::ChainSched, false, true>(lds, 1024, S, E);
        if (BOTH(6) || !LASTREP(6)) GRID_BAR();
    }

    for (int rep = 0; rep < NREP(7); ++rep) if (IN(7)) {
        pg8::StaticSched S; S.T.init(MTOK, DM, G, bx); S.A = (const char*)(ws + WS_MIXED); S.B = (const char*)(ws + WS_WOUT); S.K = DM;
        pg8::EpiOut E{(const float*)args.in[0], MOD, args.out};
        pg8::gemm_phase<pg8::EpiOut, pg8::StaticSched, false>(lds, DM, S, E);
        if (BOTH(7) || !LASTREP(7)) GRID_BAR();
    }

    for (int rep = 0; rep < NREP(8); ++rep) if (IN(8)) {
        PHASE_IDS();
        bf16_t* H2 = (bf16_t*)(ws + WS_H); const bool dry = !LASTREP(8); const size_t alt = dry ? (WS_KVRAW + 8 * MiB - WS_TOKINFO) : 0; gu32* ecn = ctl + CW_CNT + (dry ? 64 : 0);
        int* tokinfo = (int*)(ws + WS_TOKINFO + alt); int* tokof = (int*)(ws + WS_TOKOF + alt); float* combof = (float*)(ws + WS_COMBOF + alt);
        const float* GS2 = (const float*)(ws + WS_GS2); const float* CVEC = (const float*)(ws + WS_CVEC);
        const bf16_t* whi = (const bf16_t*)(ws + WS_WRT); const bf16_t* wlo = whi + 48 * DM;
        LAS float* red = (LAS float*)lds; LAS float* ssqp = (LAS float*)(lds + 24576); LAS float* rsl = (LAS float*)(lds + 25088);
        const int r = lane & 15, kq = lane >> 4;
        for (int rt = bx; rt < MTOK / 16; rt += G) {
            const int row0 = rt * 16, b = row0 >> 11;
            const float* xrow = args.out + (size_t)(row0 + r) * DM + 256 * wave + 8 * kq;
            const float* gsr = GS2 + b * DM + 256 * wave + 8 * kq;
            float v[8][8]; float ssq = 0.f;
            f32x4 acc[3] = {(f32x4){0.f, 0.f, 0.f, 0.f}, (f32x4){0.f, 0.f, 0.f, 0.f}, (f32x4){0.f, 0.f, 0.f, 0.f}};
#pragma unroll
            for (int ks = 0; ks < 8; ++ks) {
                const f32x4 x0 = *(const f32x4*)(xrow + 32 * ks), x1 = *(const f32x4*)(xrow + 32 * ks + 4), g0 = *(const f32x4*)(gsr + 32 * ks), g1 = *(const f32x4*)(gsr + 32 * ks + 4);
                unsigned hw[8], lw[8];
#pragma unroll
                for (int e = 0; e < 8; ++e) { const float xv = (e < 4) ? x0[e & 3] : x1[e & 3]; const float gv = (e < 4) ? g0[e & 3] : g1[e & 3];
                    ssq += xv * xv; const float t = xv * gv; v[ks][e] = t; hw[e] = f2bf(t); lw[e] = f2bf(t - __builtin_bit_cast(float, hw[e] << 16)); }
                const u32x4 ah = {hw[0] | (hw[1] << 16), hw[2] | (hw[3] << 16), hw[4] | (hw[5] << 16), hw[6] | (hw[7] << 16)};
                const u32x4 al = {lw[0] | (lw[1] << 16), lw[2] | (lw[3] << 16), lw[4] | (lw[5] << 16), lw[6] | (lw[7] << 16)};
                const bf16x8 ahi = __builtin_bit_cast(bf16x8, ah), alo = __builtin_bit_cast(bf16x8, al);
#pragma unroll
                for (int nt = 0; nt < 3; ++nt) { const size_t wo = (size_t)(16 * nt + r) * DM + 256 * wave + 32 * ks + 8 * kq;
                    const bf16x8 bh = *(const bf16x8*)(whi + wo), bl = *(const bf16x8*)(wlo + wo);
                    acc[nt] = __builtin_amdgcn_mfma_f32_16x16x32_bf16(ahi, bh, acc[nt], 0, 0, 0);
                    acc[nt] = __builtin_amdgcn_mfma_f32_16x16x32_bf16(alo, bh, acc[nt], 0, 0, 0);
                    acc[nt] = __builtin_amdgcn_mfma_f32_16x16x32_bf16(ahi, bl, acc[nt], 0, 0, 0); }
            }
            ssq += __shfl_xor(ssq, 16); ssq += __shfl_xor(ssq, 32);
            if (kq == 0) ssqp[wave * 16 + r] = ssq;
#pragma unroll
            for (int nt = 0; nt < 3; ++nt)
#pragma unroll
                for (int i = 0; i < 4; ++i) red[(wave * 16 + 4 * kq + i) * 48 + 16 * nt + r] = acc[nt][i];
            __syncthreads();
            LAS float* lgl = (LAS float*)(lds + 25600);
            for (int i = tid; i < 16 * 36; i += 512) { const int tk = i / 36, o = i - tk * 36; float sq = 0.f, a = 0.f;
#pragma unroll
                for (int w = 0; w < 8; ++w) { sq += ssqp[w * 16 + tk]; a += red[(w * 16 + tk) * 48 + o]; }
                const float rstd = 1.f / sqrtf(sq * (1.f / DM) + EPS);
                if (o == 0) rsl[tk] = rstd;
                lgl[tk * 48 + o] = a * rstd + CVEC[b * 48 + o]; }
            __syncthreads();
            if (tid < 16) {
                const int m = row0 + tid;
                const LAS float* lg = lgl + tid * 48;
                int gs = 0; float gmx = lg[32];
#pragma unroll
                for (int i = 1; i < 4; ++i) if (lg[32 + i] > gmx) { gmx = lg[32 + i]; gs = i; }
                float gsum = 0.f;
#pragma unroll
                for (int i = 0; i < 4; ++i) gsum += __expf(lg[32 + i] - gmx);
                const float gwt = 1.f / gsum;
                float el[8];
#pragma unroll
                for (int i = 0; i < 8; ++i) { float a = lg[i]; a = (gs == 1) ? lg[8 + i] : a; a = (gs == 2) ? lg[16 + i] : a; a = (gs == 3) ? lg[24 + i] : a; el[i] = a; }
                int i0 = 0; float m0 = el[0];
#pragma unroll
                for (int i = 1; i < 8; ++i) if (el[i] > m0) { m0 = el[i]; i0 = i; }
                int i1 = -1; float m1 = -INFINITY;
#pragma unroll
                for (int i = 0; i < 8; ++i) if (i != i0 && el[i] > m1) { m1 = el[i]; i1 = i; }
                const float p1 = __expf(m1 - m0), w0 = gwt / (1.f + p1), w1 = gwt * p1 / (1.f + p1);
                const int e0 = gs * 8 + i0, e1 = gs * 8 + i1;
                const int pos0 = (int)__hip_atomic_fetch_add(ecn + e0, 1u, RLX_AGENT), pos1 = (int)__hip_atomic_fetch_add(ecn + e1, 1u, RLX_AGENT);
                tokof[e0 * 8192 + pos0] = m; combof[e0 * 8192 + pos0] = w0; tokof[e1 * 8192 + pos1] = m; combof[e1 * 8192 + pos1] = w1;
                tokinfo[m * 4 + 0] = e0; tokinfo[m * 4 + 1] = pos0; tokinfo[m * 4 + 2] = e1; tokinfo[m * 4 + 3] = pos1;
            }
            __syncthreads();
            {
                const float rstd = rsl[r];
                const float* shr = MOD + b * 12288 + 6144 + 256 * wave + 8 * kq;
                bf16_t* orow = H2 + (size_t)(row0 + r) * DM + 256 * wave + 8 * kq;
#pragma unroll
                for (int ks = 0; ks < 8; ++ks) { const f32x4 s0 = *(const f32x4*)(shr + 32 * ks), s1 = *(const f32x4*)(shr + 32 * ks + 4);
                    u32x4 w; w.x = pk2(v[ks][0] * rstd + s0[0], v[ks][1] * rstd + s0[1]); w.y = pk2(v[ks][2] * rstd + s0[2], v[ks][3] * rstd + s0[3]);
                    w.z = pk2(v[ks][4] * rstd + s1[0], v[ks][5] * rstd + s1[1]); w.w = pk2(v[ks][6] * rstd + s1[2], v[ks][7] * rstd + s1[3]);
                    *(u32x4*)(orow + 32 * ks) = w; }
            }
            __syncthreads();
        }
        if (LASTREP(8)) bg_drain(args, lds, BG_GU_WITEMS / 8);
        if (BOTH(8) || !LASTREP(8)) GRID_BAR();
    }

    LAS int* tstart = (LAS int*)(lds + MISC_OFF + 128); LAS int* ecnt = (LAS int*)(lds + MISC_OFF + 128 + 33 * 4 + 12);
    if (IN(9) || IN(10) || IN(11)) {
        __syncthreads();
        if (threadIdx.x == 0) { int acc = 0; for (int e = 0; e < 32; ++e) { const int c = (int)__hip_atomic_load(ctl + CW_CNT + e, RLX_AGENT); ecnt[e] = c; tstart[e] = acc; acc += (c + 255) >> 8; } tstart[32] = acc; }
        __syncthreads();
    }

    for (int rep = 0; rep < NREP(9); ++rep) if (IN(9)) {
        pg8::MoeUpSched S{tstart, ecnt, (const int*)(ws + WS_TOKOF), (const char*)(ws + WS_H), (const char*)(ws + WS_WGU), G, bx};
        pg8::EpiMoeUp E{(const float*)(ws + WS_COMBOF), (bf16_t*)(ws + WS_ACT)};
        pg8::gemm_phase<pg8::EpiMoeUp, pg8::MoeUpSched, true>(lds, DM, S, E);
        if (LASTREP(9)) { bg_slack(args, lds, 9, G); bg_drain(args, lds, BG_BLOCK_ITEMS); }
        if (BOTH(9) || !LASTREP(9)) GRID_BAR();
    }

    for (int rep = 0; rep < NREP(10); ++rep) if (IN(10)) {
        pg8::MoeDownSched S{tstart, (const char*)(ws + WS_ACT), (const char*)(ws + WS_WD), G, bx};
        pg8::EpiBf16 E{(bf16_t*)(ws + WS_Y), DM};
        pg8::gemm_phase<pg8::EpiBf16, pg8::MoeDownSched, false>(lds, DFF, S, E);
        if (BOTH(10) || !LASTREP(10)) GRID_BAR();
    }

    for (int rep = 0; rep < NREP(11); ++rep) if (IN(11)) {
        PHASE_IDS();
        const bf16_t* Y = (const bf16_t*)(ws + WS_Y); const int* tokinfo = (const int*)(ws + WS_TOKINFO);
        for (int m = gw; m < MTOK; m += NGW) {
            const int b = m >> 11;
            const int e0 = tokinfo[m * 4], p0 = tokinfo[m * 4 + 1], e1 = tokinfo[m * 4 + 2], p1 = tokinfo[m * 4 + 3];
            const size_t s0 = (size_t)tstart[e0] * 256 + p0, s1 = (size_t)tstart[e1] * 256 + p1;
            const f32x4* xr = (const f32x4*)(args.out + (size_t)m * DM) + lane;
            f32x4* ow = (LASTREP(11) ? (f32x4*)(args.out + (size_t)m * DM) : (f32x4*)(ws + WS_MIXED + (size_t)m * DM * 4)) + lane;
            const u32x2* y0 = (const u32x2*)(Y + s0 * DM) + lane; const u32x2* y1 = (const u32x2*)(Y + s1 * DM) + lane;
#pragma unroll
            for (int j = 0; j < 8; ++j) { const int k = 4 * (lane + 64 * j); const f32x4 gt = *(const f32x4*)(MOD + b * 12288 + 10240 + k);
                const u32x2 a = y0[64 * j], c = y1[64 * j]; const f32x4 xv = xr[64 * j];
                const f32x4 mo = {bflo(a.x) + bflo(c.x), bfhi(a.x) + bfhi(c.x), bflo(a.y) + bflo(c.y), bfhi(a.y) + bfhi(c.y)};
                ow[64 * j] = xv + gt * mo; }
        }
        if (!LASTREP(11)) GRID_BAR();
    }
#undef IN
#undef BOTH
#undef GRID_BAR
}

extern "C" void kernel_launch(void* const* d_in, const int* in_sizes, int n_in, void* d_out, int out_size, void* d_ws, size_t ws_size, hipStream_t stream) {
    static int grid = 0;
    if (grid == 0) {
        if (n_in != 28 || in_sizes[0] != MTOK * DM || out_size != MTOK * DM || ws_size < WS_END) {
            fprintf(stderr, "kernel_launch: unexpected shapes (n_in %d in0 %d out %d ws %zu need %zu)\n", n_in, n_in > 0 ? in_sizes[0] : -1, out_size, ws_size, (size_t)WS_END); grid = -1; return; }
        int dev = 0, cus = 0, per_cu = 0;
        if (hipGetDevice(&dev) != hipSuccess || hipDeviceGetAttribute(&cus, hipDeviceAttributeMultiprocessorCount, dev) != hipSuccess) { grid = -1; return; }
        if (hipFuncSetAttribute((const void*)mk_fwd, hipFuncAttributeMaxDynamicSharedMemorySize, LDS_BYTES) != hipSuccess) { fprintf(stderr, "kernel_launch: hipFuncSetAttribute failed\n"); grid = -1; return; }
        if (hipOccupancyMaxActiveBlocksPerMultiprocessor(&per_cu, (const void*)mk_fwd, NWAVES * 64, LDS_BYTES) != hipSuccess || per_cu < 1)
            fprintf(stderr, "kernel_launch: occupancy query reports %d blocks per CU\n", per_cu);
        (void)hipGetLastError();
        grid = cus;
    }
    if (grid < 0) return;
    (void)hipMemsetAsync((char*)d_ws + WS_CTL, 0, CTL_ZERO_BYTES, stream);
    Args a{};
    for (int i = 0; i < 28; ++i) a.in[i] = d_in[i];
    a.out = (float*)d_out; a.ws = (unsigned char*)d_ws;
    for (int i = 0; i < 32; ++i) a.inv_freq[i] = (float)pow(10000.0, -(double)(2 * i) / 64.0);
#if MK_N_LAUNCHES == 1
    a.ph_lo = 0; a.ph_hi = PER_PHASE; a.li = 0;
    hipLaunchKernelGGL(mk_fwd, dim3(grid), dim3(NWAVES * 64), LDS_BYTES, stream, a);
#else
    for (int li = 0; li < PER_PHASE; ++li) { a.ph_lo = li; a.ph_hi = li + 1; a.li = li;
        hipLaunchKernelGGL(mk_fwd, dim3(grid), dim3(NWAVES * 64), LDS_BYTES, stream, a); }
#endif
}
```
